# Optimizing an MI355X kernel written in HIP

```python
import math
import jax, jax.numpy as jnp
from jax import lax
import numpy as np

D_MODEL = 2048
BATCH = 16
SEQ = 2048
DEPTH = 4

D_MIX = D_MODEL
ATT_WIDTH = D_MIX // 2
SSM_WIDTH = D_MIX - ATT_WIDTH
ATT_HEAD_DIM = 128
ATT_HEADS = ATT_WIDTH // ATT_HEAD_DIM
ATT_BLOCK = 128
SSM_HEAD_DIM = 64
SSM_HEADS = SSM_WIDTH // SSM_HEAD_DIM
SSM_GROUPS = 2
SSM_HEADS_PER_GROUP = SSM_HEADS // SSM_GROUPS
SSM_STATE = 128
CONV_WIDTH = 4
CONV_DIM = SSM_WIDTH + 2 * SSM_GROUPS * SSM_STATE
SSD_CHUNK = 128
D_FF = -(-8 * D_MODEL // (3 * 256)) * 256
IN_DIM = 3 * ATT_WIDTH + SSM_WIDTH + CONV_DIM + SSM_HEADS
EPS = 1e-6

kernel_name = 'hymba_stickbreaking_ssd_swiglu'


def rmsnorm(x, g):
    xf = x.astype(jnp.float32)
    y = xf * lax.rsqrt(jnp.mean(xf * xf, axis=-1, keepdims=True) + EPS)
    return (y * g.astype(jnp.float32)).astype(x.dtype)


def stick_breaking_attention(q, k, v):
    bsz, s, h, dh = q.shape
    nb = s // ATT_BLOCK
    scale = dh ** -0.5
    qf = q.astype(jnp.float32).transpose(0, 2, 1, 3)
    kf = k.astype(jnp.float32).transpose(0, 2, 1, 3)
    vf = v.astype(jnp.float32).transpose(0, 2, 1, 3)
    q_blocks = qf.reshape(bsz, h, nb, ATT_BLOCK, dh).transpose(2, 0, 1, 3, 4)
    key_pos = jnp.arange(s)

    def one_block(args):
        qb, blk = args
        z = jnp.einsum('bhqd,bhkd->bhqk', qb, kf) * scale
        query_pos = blk * ATT_BLOCK + jnp.arange(ATT_BLOCK)
        mask = key_pos[None, :] < query_pos[:, None]
        log_beta = jax.nn.log_sigmoid(z)
        log_remain = jnp.where(mask, log_beta - z, 0.0)
        later = lax.cumsum(log_remain, axis=3, reverse=True) - log_remain
        weights = jnp.where(mask, jnp.exp(log_beta + later), 0.0)
        return jnp.einsum('bhqk,bhkd->bhqd', weights, vf)

    out = lax.map(one_block, (q_blocks, jnp.arange(nb)))
    out = out.transpose(1, 0, 3, 2, 4).reshape(bsz, s, h, dh)
    return out.astype(q.dtype)


def causal_depthwise_conv(u, w, bias):
    s = u.shape[1]
    up = jnp.pad(u, ((0, 0), (CONV_WIDTH - 1, 0), (0, 0)))
    out = bias
    for i in range(CONV_WIDTH):
        out = out + up[:, i:i + s] * w[i]
    return out


def ssd_chunked(x, dt, a, b_in, c_in, d_skip):
    bsz, s, h, p = x.shape
    nc = s // SSD_CHUNK
    g, hg, n = SSM_GROUPS, SSM_HEADS_PER_GROUP, SSM_STATE
    xf = x.astype(jnp.float32)
    dtf = dt.astype(jnp.float32)
    xdt = (xf * dtf[..., None]).reshape(bsz, nc, SSD_CHUNK, g, hg, p)
    bc = b_in.astype(jnp.float32).reshape(bsz, nc, SSD_CHUNK, g, n)
    cc = c_in.astype(jnp.float32).reshape(bsz, nc, SSD_CHUNK, g, n)
    da = (dtf * a.astype(jnp.float32)).reshape(bsz, nc, SSD_CHUNK, g, hg)
    a_cum = jnp.cumsum(da, axis=2)
    pos = jnp.arange(SSD_CHUNK)
    causal = (pos[:, None] >= pos[None, :])[:, :, None, None]
    seg = a_cum[:, :, :, None] - a_cum[:, :, None, :]
    decay = jnp.exp(jnp.where(causal, seg, -jnp.inf))
    cb = jnp.einsum('bclgn,bcsgn->bclsg', cc, bc)
    y_diag = jnp.einsum('bclsg,bclsgi,bcsgip->bclgip', cb, decay, xdt)
    decay_to_end = jnp.exp(a_cum[:, :, -1:] - a_cum)
    states = jnp.einsum('bcsgn,bcsgi,bcsgip->bcgipn', bc, decay_to_end, xdt)
    chunk_decay = jnp.exp(a_cum[:, :, -1])

    def step(h_prev, inp):
        st, dec = inp
        return h_prev * dec[..., None, None] + st, h_prev

    h0 = jnp.zeros((bsz, g, hg, p, n), jnp.float32)
    _, h_in = lax.scan(step, h0, (states.transpose(1, 0, 2, 3, 4, 5), chunk_decay.transpose(1, 0, 2, 3)))
    h_in = h_in.transpose(1, 0, 2, 3, 4, 5)
    y_off = jnp.einsum('bclgn,bcgipn,bclgi->bclgip', cc, h_in, jnp.exp(a_cum))
    y = (y_diag + y_off).reshape(bsz, s, h, p) + xf * d_skip.astype(jnp.float32)[:, None]
    return y


def hybrid_layer(x, norm_mix, w_in, q_gain, k_gain, conv_w, conv_b, dt_bias, a_log, d_skip,
                 attn_out_gain, ssm_out_gain, w_out, norm_ffn, w_gate, w_up, w_down):
    bsz, s, _ = x.shape
    h = rmsnorm(x, norm_mix)
    proj = h @ w_in
    splits = [ATT_WIDTH, 2 * ATT_WIDTH, 3 * ATT_WIDTH, 3 * ATT_WIDTH + SSM_WIDTH,
              3 * ATT_WIDTH + SSM_WIDTH + CONV_DIM]
    q, k, v, z, xbc, dt = jnp.split(proj, splits, axis=-1)

    q = rmsnorm(q.reshape(bsz, s, ATT_HEADS, ATT_HEAD_DIM), q_gain)
    k = rmsnorm(k.reshape(bsz, s, ATT_HEADS, ATT_HEAD_DIM), k_gain)
    v = v.reshape(bsz, s, ATT_HEADS, ATT_HEAD_DIM)
    o_att = stick_breaking_attention(q, k, v).reshape(bsz, s, ATT_WIDTH)
    o_att = rmsnorm(o_att, attn_out_gain)

    xbc = jax.nn.silu(causal_depthwise_conv(xbc, conv_w, conv_b))
    xs, bm, cm = jnp.split(xbc, [SSM_WIDTH, SSM_WIDTH + SSM_GROUPS * SSM_STATE], axis=-1)
    dt = jax.nn.softplus(dt.astype(jnp.float32) + dt_bias.astype(jnp.float32))
    a = -jnp.exp(a_log.astype(jnp.float32))
    y = ssd_chunked(xs.reshape(bsz, s, SSM_HEADS, SSM_HEAD_DIM), dt, a,
                    bm.reshape(bsz, s, SSM_GROUPS, SSM_STATE),
                    cm.reshape(bsz, s, SSM_GROUPS, SSM_STATE), d_skip)
    y = y.reshape(bsz, s, SSM_WIDTH) * jax.nn.silu(z.astype(jnp.float32))
    yg = y.reshape(bsz, s, SSM_GROUPS, SSM_WIDTH // SSM_GROUPS)
    yg = yg * lax.rsqrt(jnp.mean(yg * yg, axis=-1, keepdims=True) + EPS)
    o_ssm = (yg.reshape(bsz, s, SSM_WIDTH) * ssm_out_gain.astype(jnp.float32)).astype(x.dtype)

    x = x + jnp.concatenate([o_att, o_ssm], axis=-1) @ w_out

    h = rmsnorm(x, norm_ffn)
    x = x + (jax.nn.silu(h @ w_gate) * (h @ w_up)) @ w_down
    return x


def setup_inputs(seed: int = 0) -> dict:
    key = jax.random.key(seed)
    ks = jax.random.split(key, 18)
    f32 = jnp.float32

    def normal(k, shape, scale):
        return jax.random.normal(k, shape, f32) * scale

    x = normal(ks[0], (BATCH, SEQ, D_MODEL), 1.0)
    norm_mix = 1.0 + normal(ks[1], (DEPTH, D_MODEL), 0.02)
    w_in = normal(ks[2], (DEPTH, D_MODEL, IN_DIM), D_MODEL ** -0.5)
    q_gain = 1.0 + normal(ks[3], (DEPTH, ATT_HEAD_DIM), 0.02)
    k_gain = 1.0 + normal(ks[4], (DEPTH, ATT_HEAD_DIM), 0.02)
    conv_w = normal(ks[5], (DEPTH, CONV_WIDTH, CONV_DIM), CONV_WIDTH ** -0.5)
    conv_b = normal(ks[6], (DEPTH, CONV_DIM), 0.01)
    dt0 = jnp.exp(jax.random.uniform(ks[7], (DEPTH, SSM_HEADS), f32, math.log(1e-3), math.log(1e-1)))
    dt_bias = dt0 + jnp.log(-jnp.expm1(-dt0))
    a_log = jnp.log(jax.random.uniform(ks[8], (DEPTH, SSM_HEADS), f32, 1.0, 16.0))
    d_skip = 1.0 + normal(ks[9], (DEPTH, SSM_HEADS), 0.02)
    attn_out_gain = 1.0 + normal(ks[10], (DEPTH, ATT_WIDTH), 0.02)
    ssm_out_gain = 1.0 + normal(ks[11], (DEPTH, SSM_WIDTH), 0.02)
    w_out = normal(ks[12], (DEPTH, D_MIX, D_MODEL), D_MIX ** -0.5)
    norm_ffn = 1.0 + normal(ks[13], (DEPTH, D_MODEL), 0.02)
    w_gate = normal(ks[14], (DEPTH, D_MODEL, D_FF), D_MODEL ** -0.5)
    w_up = normal(ks[15], (DEPTH, D_MODEL, D_FF), D_MODEL ** -0.5)
    w_down = normal(ks[16], (DEPTH, D_FF, D_MODEL), D_FF ** -0.5)
    return {'x': x, 'norm_mix': norm_mix, 'w_in': w_in, 'q_gain': q_gain, 'k_gain': k_gain,
            'conv_w': conv_w, 'conv_b': conv_b, 'dt_bias': dt_bias, 'a_log': a_log, 'd_skip': d_skip,
            'attn_out_gain': attn_out_gain, 'ssm_out_gain': ssm_out_gain, 'w_out': w_out,
            'norm_ffn': norm_ffn, 'w_gate': w_gate, 'w_up': w_up, 'w_down': w_down}


def reference(x, norm_mix, w_in, q_gain, k_gain, conv_w, conv_b, dt_bias, a_log, d_skip,
              attn_out_gain, ssm_out_gain, w_out, norm_ffn, w_gate, w_up, w_down):
    for i in range(DEPTH):
        x = hybrid_layer(x, norm_mix[i], w_in[i], q_gain[i], k_gain[i], conv_w[i], conv_b[i],
                         dt_bias[i], a_log[i], d_skip[i], attn_out_gain[i], ssm_out_gain[i],
                         w_out[i], norm_ffn[i], w_gate[i], w_up[i], w_down[i])
    return x
```

```cpp
#include <hip/hip_runtime.h>
#include <cstdio>
#include <cstdint>
namespace pg8 {
#define PG8_LAS __attribute__((address_space(3)))
typedef unsigned short bf16_t;
typedef short bf16x8 __attribute__((ext_vector_type(8)));
typedef float f32x4 __attribute__((ext_vector_type(4)));
typedef unsigned u32x4 __attribute__((ext_vector_type(4)));
constexpr int BM = 256, BK = 64, HALF = 128, HTB = HALF * BK * 2  , STAGE_BYTES = 8 * HTB, NXCD = 8, WGM = 8;

__host__ __device__ __forceinline__ int lds_byte(int r, int c) { const int st = (r >> 4) * 2 + (c >> 5), rr = r & 15, cc = c & 31, ob = rr * 64 + cc * 2; return st * 1024 + (ob ^ (((ob >> 9) & 1) << 5)); }
__host__ __device__ __forceinline__ void stage_rc(int b, int& R, int& C) { const int st = b / 1024, sb = b % 1024, swz = sb ^ (((sb >> 9) & 1) << 5); R = (st >> 1) * 16 + swz / 64; C = (st & 1) * 32 + (swz % 64) / 2; }
__host__ __device__ __forceinline__ int perm32(int rho) { const int n = rho >> 4, i = rho & 15; return 8 * (i >> 2) + 4 * n + (i & 3); }

struct Unit { int pm, pn, seg; };
struct Gemm { const bf16_t* A; const bf16_t* Bt; int M, N, K, lda, ldb; };

struct StaticOrder {
    int nM, nN, nwg, G, c, wgm;
    __host__ __device__ void init(int M, int N, int G_, int c_, int wgm_ = WGM) { nM = M / BM; nN = N / BM; nwg = nM * nN; G = G_; c = c_; wgm = wgm_; }
    __host__ __device__ bool next(int i, Unit& u) const {
        const long L = (long)i * G + c; if (L >= nwg) return false;
        int wgid = (int)L; { const int q = nwg / NXCD, r = nwg % NXCD, xcd = wgid % NXCD, off = wgid / NXCD; wgid = (xcd < r ? xcd * (q + 1) : r * (q + 1) + (xcd - r) * q) + off; }
        const int nig = wgm * nN, gid = wgid / nig, fm = gid * wgm, gsz = (nM - fm) < wgm ? (nM - fm) : wgm;
        u.pm = fm + ((wgid % nig) % gsz); u.pn = (wgid % nig) / gsz; u.seg = 0; return true;
    }
    static constexpr bool KSEG = false;
    __host__ __device__ int kt0(const Unit&) const { return 0; }
    __host__ __device__ int nkt(const Unit&, int ntK) const { return ntK; }
    __host__ __device__ bool fresh(const Unit&) const { return true; }
    __device__ __forceinline__ void a_ready(const Unit&) const {}
    __device__ __forceinline__ void done(const Unit&) const {}
};
struct KSegOrder : StaticOrder {
    static constexpr bool KSEG = true;
    __host__ __device__ bool next(int i, Unit& u) const { if (!StaticOrder::next(i / 3, u)) return false; u.seg = i % 3; return true; }
    __host__ __device__ int kt0(const Unit& u) const { return u.seg == 0 ? 0 : (u.seg == 1 ? 16 : 24); }
    __host__ __device__ int nkt(const Unit& u, int) const { return u.seg == 0 ? 16 : 8; }
    __host__ __device__ bool fresh(const Unit& u) const { return u.seg == 0; }
};

__device__ __forceinline__ unsigned cvt_pk_bf16(float lo, float hi) { unsigned r; asm volatile("v_cvt_pk_bf16_f32 %0, %1, %2" : "=v"(r) : "v"(lo), "v"(hi)); return r; }
constexpr float RMS_EPS = 1e-6f;
__device__ __forceinline__ float row_sumsq32(const float* ssq, int row) { const f32x4* p = (const f32x4*)(ssq + (size_t)row * 32); float s = 0.f;
#pragma unroll
    for (int i = 0; i < 8; ++i) { const f32x4 v = p[i]; s += (v[0] + v[1]) + (v[2] + v[3]); }
    return s; }
__device__ __forceinline__ float row_rstd(const float* ssq, int row, float inv_n) { return 1.0f / sqrtf(row_sumsq32(ssq, row) * inv_n + RMS_EPS); }
__device__ __forceinline__ float silu_f(float v) { return v * __builtin_amdgcn_rcpf(1.0f + __expf(-v)); }

constexpr float QSCALE = 0.08838834764831845f * 1.4426950408889634f;
struct EpiProj {
    static constexpr bool PERM = true, AFTER_DRAIN = false, RESCALE = false;
    bf16_t* O; int ldc; const float* ssq; float inv_n; const PG8_LAS float* gains; PG8_LAS float* xch; const PG8_LAS float* tbl; int gid0; size_t toff;
    __device__ __forceinline__ float rstd_of(const Unit& u, int rloc, int row) const { return tbl[(((u.pm >> 3) - gid0) & 3) * 256 + rloc]; }
    __device__ __forceinline__ void operator()(const f32x4 (&acc)[2][2][4][2], const Unit& u, int wr, int wc, int fr, int fq) const {
        asm volatile("" : "+v"(fr), "+v"(fq));
        const int row0 = u.pm * BM + wr * 64 + fr, col0 = u.pn * BM + wc * 32 + 8 * fq;
        bf16_t* const Ob = O + (size_t)(u.pm >> 4) * toff;
        if (u.pn < 8) {
#pragma unroll
            for (int ai = 0; ai < 2; ++ai)
#pragma unroll
                for (int m = 0; m < 4; ++m) { const int rloc = ai * HALF + wr * 64 + m * 16 + fr;
#pragma unroll
                    for (int bj = 0; bj < 2; ++bj) { const f32x4 a = acc[ai][bj][m][0], b = acc[ai][bj][m][1];
                        float ss = ((a[0] * a[0] + a[1] * a[1]) + (a[2] * a[2] + a[3] * a[3])) + ((b[0] * b[0] + b[1] * b[1]) + (b[2] * b[2] + b[3] * b[3]));
                        ss += __shfl_xor(ss, 16); ss += __shfl_xor(ss, 32);
                        if (fq == 0) xch[(rloc * 2 + bj) * 4 + wc] = ss; } }
            asm volatile("s_waitcnt lgkmcnt(0)" ::: "memory"); __builtin_amdgcn_s_barrier(); asm volatile("" ::: "memory");
            const PG8_LAS float* gp = gains + ((u.pn < 4) ? 0 : 128) + wc * 32 + 8 * fq;
            const f32x4 g0 = *(const PG8_LAS f32x4*)gp, g1 = *(const PG8_LAS f32x4*)(gp + 4);
#pragma unroll
            for (int ai = 0; ai < 2; ++ai)
#pragma unroll
                for (int m = 0; m < 4; ++m) { const int rloc = ai * HALF + wr * 64 + m * 16 + fr, row = row0 + ai * HALF + m * 16; const float rs = rstd_of(u, rloc, row);
                    bf16_t* rowp = Ob + (size_t)row * ldc + col0;
#pragma unroll
                    for (int bj = 0; bj < 2; ++bj) { const f32x4 p = *(const PG8_LAS f32x4*)(xch + (rloc * 2 + bj) * 4); const float tot = (p[0] + p[1]) + (p[2] + p[3]);
                        const float hr = rs / sqrtf(tot * rs * rs * (1.0f / 128.0f) + RMS_EPS);
                        const f32x4 v0 = acc[ai][bj][m][0] * hr * g0, v1 = acc[ai][bj][m][1] * hr * g1;
                        u32x4 w; w.x = cvt_pk_bf16(v0[0], v0[1]); w.y = cvt_pk_bf16(v0[2], v0[3]); w.z = cvt_pk_bf16(v1[0], v1[1]); w.w = cvt_pk_bf16(v1[2], v1[3]);
                        *(u32x4*)(rowp + bj * HALF) = w; } }
        } else if (u.pn >= 12 && u.pn < 16) {
#pragma unroll
        for (int ai = 0; ai < 2; ++ai)
#pragma unroll
            for (int m = 0; m < 4; ++m) { const int row = row0 + ai * HALF + m * 16; const float rs = rstd_of(u, ai * HALF + wr * 64 + m * 16 + fr, row);
                bf16_t* rowp = Ob + (size_t)row * ldc + col0;
#pragma unroll
                for (int bj = 0; bj < 2; ++bj) { f32x4 v0 = acc[ai][bj][m][0] * rs, v1 = acc[ai][bj][m][1] * rs;
#pragma unroll
                    for (int j = 0; j < 4; ++j) { v0[j] = v0[j] * __builtin_amdgcn_rcpf(1.0f + __expf(-v0[j])); v1[j] = v1[j] * __builtin_amdgcn_rcpf(1.0f + __expf(-v1[j])); }
                    u32x4 w; w.x = cvt_pk_bf16(v0[0], v0[1]); w.y = cvt_pk_bf16(v0[2], v0[3]); w.z = cvt_pk_bf16(v1[0], v1[1]); w.w = cvt_pk_bf16(v1[2], v1[3]);
                    *(u32x4*)(rowp + bj * HALF) = w; } }
        } else {
#pragma unroll
        for (int ai = 0; ai < 2; ++ai)
#pragma unroll
            for (int m = 0; m < 4; ++m) { const int row = row0 + ai * HALF + m * 16; const float rs = rstd_of(u, ai * HALF + wr * 64 + m * 16 + fr, row);
                bf16_t* rowp = Ob + (size_t)row * ldc + col0;
#pragma unroll
                for (int bj = 0; bj < 2; ++bj) { const f32x4 v0 = acc[ai][bj][m][0] * rs, v1 = acc[ai][bj][m][1] * rs;
                    u32x4 w; w.x = cvt_pk_bf16(v0[0], v0[1]); w.y = cvt_pk_bf16(v0[2], v0[3]); w.z = cvt_pk_bf16(v1[0], v1[1]); w.w = cvt_pk_bf16(v1[2], v1[3]);
                    *(u32x4*)(rowp + bj * HALF) = w; } }
        }
    }
};
struct EpiSwiGLU {
    static constexpr bool PERM = true, AFTER_DRAIN = false, RESCALE = false;
    bf16_t* O; int ldc; const float* ssq; float inv_n; const PG8_LAS float* tbl; int gid0;
    __device__ __forceinline__ void operator()(const f32x4 (&acc)[2][2][4][2], const Unit& u, int wr, int wc, int fr, int fq) const {
        asm volatile("" : "+v"(fr), "+v"(fq));
        const int row0 = u.pm * BM + wr * 64 + fr, col0 = u.pn * HALF + wc * 32 + 8 * fq;
#pragma unroll
        for (int ai = 0; ai < 2; ++ai)
#pragma unroll
            for (int m = 0; m < 4; ++m) { const int row = row0 + ai * HALF + m * 16; const float rs = tbl[(((u.pm >> 3) - gid0) & 3) * 256 + ai * HALF + wr * 64 + m * 16 + fr];
                const f32x4 g0 = acc[ai][0][m][0] * rs, g1 = acc[ai][0][m][1] * rs, u0 = acc[ai][1][m][0] * rs, u1 = acc[ai][1][m][1] * rs;
                float h[8];
#pragma unroll
                for (int j = 0; j < 4; ++j) { h[j] = silu_f(g0[j]) * u0[j]; h[4 + j] = silu_f(g1[j]) * u1[j]; }
                u32x4 w; w.x = cvt_pk_bf16(h[0], h[1]); w.y = cvt_pk_bf16(h[2], h[3]); w.z = cvt_pk_bf16(h[4], h[5]); w.w = cvt_pk_bf16(h[6], h[7]);
                *(u32x4*)(O + (size_t)row * ldc + col0) = w; }
    }
};
template <bool RS> struct EpiResid {
    static constexpr bool PERM = true, AFTER_DRAIN = false, RESCALE = false;
    const bf16_t* xbi; bf16_t* xb; float* outf; float* ssq_out; int ldc; int final_f32; const PG8_LAS float* ftab;
    __device__ __forceinline__ void mid(f32x4 (&acc)[2][2][4][2], const Unit& u, int wr, int fr) const {
        asm volatile("" : "+v"(fr));
        const PG8_LAS float* f = ftab + ((u.pm >> 2) & 3) * 768 + u.seg * 256 + wr * 64 + fr;
#pragma unroll
        for (int ai = 0; ai < 2; ++ai)
#pragma unroll
            for (int m = 0; m < 4; ++m) { const float sc = f[ai * HALF + m * 16];
#pragma unroll
                for (int bj = 0; bj < 2; ++bj)
#pragma unroll
                    for (int n = 0; n < 2; ++n) acc[ai][bj][m][n] = acc[ai][bj][m][n] * sc; }
    }
    __device__ __forceinline__ void operator()(const f32x4 (&acc)[2][2][4][2], const Unit& u, int wr, int wc, int fr, int fq) const {
        asm volatile("" : "+v"(fr), "+v"(fq));
        const int row0 = u.pm * BM + wr * 64 + fr, col0 = u.pn * BM + wc * 32 + 8 * fq;
#pragma unroll
        for (int ai = 0; ai < 2; ++ai) {
            u32x4 xv[4][2];
#pragma unroll
            for (int m = 0; m < 4; ++m)
#pragma unroll
                for (int bj = 0; bj < 2; ++bj) xv[m][bj] = *(const u32x4*)(xbi + (size_t)(row0 + ai * HALF + m * 16) * ldc + col0 + bj * HALF);
#pragma unroll
            for (int m = 0; m < 4; ++m) { const int row = row0 + ai * HALF + m * 16; float s = 0.f;
                const float s3 = RS ? ftab[((u.pm >> 2) & 3) * 768 + 512 + ai * HALF + wr * 64 + m * 16 + fr] : 1.0f;
#pragma unroll
                for (int bj = 0; bj < 2; ++bj) { const size_t off = (size_t)row * ldc + col0 + bj * HALF; const u32x4 xw = xv[m][bj];
                    f32x4 a0, a1;
                    a0[0] = __builtin_bit_cast(float, xw.x << 16); a0[1] = __builtin_bit_cast(float, xw.x & 0xffff0000u); a0[2] = __builtin_bit_cast(float, xw.y << 16); a0[3] = __builtin_bit_cast(float, xw.y & 0xffff0000u);
                    a1[0] = __builtin_bit_cast(float, xw.z << 16); a1[1] = __builtin_bit_cast(float, xw.z & 0xffff0000u); a1[2] = __builtin_bit_cast(float, xw.w << 16); a1[3] = __builtin_bit_cast(float, xw.w & 0xffff0000u);
                    a0 = a0 + acc[ai][bj][m][0] * s3; a1 = a1 + acc[ai][bj][m][1] * s3;
                    s += (a0[0] * a0[0] + a0[1] * a0[1]) + (a0[2] * a0[2] + a0[3] * a0[3]) + (a1[0] * a1[0] + a1[1] * a1[1]) + (a1[2] * a1[2] + a1[3] * a1[3]);
                    if (final_f32) { *(f32x4*)(outf + off) = a0; *(f32x4*)(outf + off + 4) = a1; }
                    else { u32x4 w; w.x = cvt_pk_bf16(a0[0], a0[1]); w.y = cvt_pk_bf16(a0[2], a0[3]); w.z = cvt_pk_bf16(a1[0], a1[1]); w.w = cvt_pk_bf16(a1[2], a1[3]); *(u32x4*)(xb + off) = w; } }
                s += __shfl_xor(s, 16); s += __shfl_xor(s, 32);
                if (fq == 0) ssq_out[(size_t)row * 32 + u.pn * 4 + wc] = s; }
        }
    }
};

template <class Epi, class Sched, bool ALIGN_EPI = false, bool SP2 = false>
__device__ __forceinline__ void gemm_phase(PG8_LAS unsigned char* lds, const Gemm g, const Sched& S, const Epi& E, const int wave_id) {
    int tid_ = threadIdx.x; asm volatile("" : "+v"(tid_));
    const int tid = tid_, wid = __builtin_amdgcn_readfirstlane(tid >> 6), lane = tid & 63, wr = wid >> 2, wc = wid & 3, fr = lane & 15, fq = lane >> 4;
    const int K = g.K, ntK = K / BK;
    unsigned voffA[2], voffB[2];
#pragma unroll
    for (int i = 0; i < 2; ++i) { int R, C; stage_rc(tid * 16 + i * 8192, R, C); const int Rb = Epi::PERM ? ((R & ~31) + perm32(R & 31)) : R;
        voffA[i] = (unsigned)(R * g.lda + C) * 2u; voffB[i] = (unsigned)(Rb * g.ldb + C) * 2u; }
    const size_t kstep = (size_t)(BK * 2);
    const size_t hstepA = (size_t)HALF * g.lda * 2, hstepB = (size_t)HALF * g.ldb * 2;
    const size_t tstepA = 2 * hstepA, tstepB = 2 * hstepB;
    const unsigned ldsw = (unsigned)wid * 1024u;
    const int aoff = lds_byte(wr * 64 + fr, fq * 8), boff = lds_byte(wc * 32 + fr, fq * 8);
#define PG8_SA(b, h) (((b) * 2 + (h)) * HTB)
#define PG8_SB(b, h) ((4 + (b) * 2 + (h)) * HTB)
#define PG8_STAGE(bufoff, gbase, voff) do { _Pragma("unroll") for (int _i = 0; _i < 2; ++_i) \
        __builtin_amdgcn_global_load_lds((const unsigned*)((const char*)(gbase) + (voff)[_i]), (PG8_LAS unsigned*)(lds + (bufoff) + ldsw + _i * 8192), 16, 0, 0); } while (0)
#define PG8_LDA(dst, b, h) do { _Pragma("unroll") for (int m = 0; m < 4; ++m) _Pragma("unroll") for (int k = 0; k < 2; ++k) dst[m][k] = *(const PG8_LAS bf16x8*)(lds + PG8_SA(b, h) + aoff + m * 2048 + k * 1024); } while (0)
#define PG8_LDB(dst, b, h) do { _Pragma("unroll") for (int n = 0; n < 2; ++n) _Pragma("unroll") for (int k = 0; k < 2; ++k) dst[n][k] = *(const PG8_LAS bf16x8*)(lds + PG8_SB(b, h) + boff + n * 2048 + k * 1024); } while (0)
#define PG8_MMA(ai, bj, At, Bt) do { __builtin_amdgcn_s_setprio(1); _Pragma("unroll") for (int m = 0; m < 4; ++m) _Pragma("unroll") for (int n = 0; n < 2; ++n) _Pragma("unroll") for (int k = 0; k < 2; ++k) \
        acc[ai][bj][m][n] = __builtin_amdgcn_mfma_f32_16x16x32_bf16(Bt[n][k], At[m][k], acc[ai][bj][m][n], 0, 0, 0); __builtin_amdgcn_s_setprio(0); } while (0)
#define PG8_WAIT_V(n) asm volatile("s_waitcnt vmcnt(" #n ")" ::: "memory")
#define PG8_WAIT_L(n) asm volatile("s_waitcnt lgkmcnt(" #n ")" ::: "memory")
#define PG8_BAR __builtin_amdgcn_s_barrier()
#define PG8_SCHED __builtin_amdgcn_sched_barrier(0)
    Unit cur, nxt; int ui = 0;
    if (!S.next(0, cur)) return;
    f32x4 acc[2][2][4][2];
#pragma unroll
    for (int a = 0; a < 2; ++a)
#pragma unroll
        for (int b = 0; b < 2; ++b)
#pragma unroll
            for (int m = 0; m < 4; ++m)
#pragma unroll
                for (int n = 0; n < 2; ++n) acc[a][b][m][n] = (f32x4){0.f, 0.f, 0.f, 0.f};
    bf16x8 At[4][2], B0[2][2], B1[2][2];
    const char* cA = (const char*)g.A + (size_t)cur.pm * tstepA + (size_t)S.kt0(cur) * kstep; const char* cB = (const char*)g.Bt + (size_t)cur.pn * tstepB + (size_t)S.kt0(cur) * kstep;
    S.a_ready(cur);
    if constexpr (SP2) {
        PG8_STAGE(PG8_SB(0, 0), cB, voffB); PG8_STAGE(PG8_SB(0, 1), cB + hstepB, voffB); PG8_STAGE(PG8_SA(0, 0), cA, voffA); PG8_STAGE(PG8_SA(0, 1), cA + hstepA, voffA);
        if (wr == 1) PG8_BAR;
        PG8_WAIT_V(2); PG8_BAR;
        PG8_STAGE(PG8_SB(1, 0), cB + kstep, voffB); PG8_STAGE(PG8_SA(1, 0), cA + kstep, voffA); PG8_STAGE(PG8_SB(1, 1), cB + hstepB + kstep, voffB);
        PG8_WAIT_V(6); PG8_BAR;
    } else {
        PG8_STAGE(PG8_SB(0, 0), cB, voffB); PG8_STAGE(PG8_SA(0, 0), cA, voffA); PG8_STAGE(PG8_SB(0, 1), cB + hstepB, voffB); PG8_STAGE(PG8_SA(0, 1), cA + hstepA, voffA);
        if (wr == 1) PG8_BAR;
        PG8_WAIT_V(4); PG8_BAR;
        PG8_STAGE(PG8_SB(1, 0), cB + kstep, voffB); PG8_STAGE(PG8_SA(1, 0), cA + kstep, voffA); PG8_STAGE(PG8_SB(1, 1), cB + hstepB + kstep, voffB);
        PG8_WAIT_V(6); PG8_BAR;
    }
    for (;;) {
        const bool has_next = S.next(ui + 1, nxt);
        const char* nA = has_next ? (const char*)g.A + (size_t)nxt.pm * tstepA + (size_t)S.kt0(nxt) * kstep : cA; const char* nB = has_next ? (const char*)g.Bt + (size_t)nxt.pn * tstepB + (size_t)S.kt0(nxt) * kstep : cB;
        const int nt = S.nkt(cur, ntK);
        for (int t = 0; t < nt; t += 2) {
            const bool last = (t == nt - 2);
            const char* a1 = cA + (size_t)(t + 1) * kstep;
            const char* a2 = last ? nA : cA + (size_t)(t + 2) * kstep; const char* b2 = last ? nB : cB + (size_t)(t + 2) * kstep;
            const char* a3 = a2 + kstep; const char* b3 = b2 + kstep;
            if (last && has_next) S.a_ready(nxt);
            if constexpr (SP2) {
            PG8_LDB(B0, 0, 0); PG8_LDB(B1, 0, 1); PG8_SCHED; PG8_LDA(At, 0, 0); PG8_STAGE(PG8_SA(1, 1), a1 + hstepA, voffA);
            PG8_WAIT_V(8); PG8_WAIT_L(0); PG8_BAR; PG8_MMA(0, 0, At, B0); PG8_MMA(0, 1, At, B1); PG8_BAR; PG8_SCHED;
            PG8_LDA(At, 0, 1); PG8_STAGE(PG8_SB(0, 0), b2, voffB); PG8_STAGE(PG8_SB(0, 1), b2 + hstepB, voffB); PG8_STAGE(PG8_SA(0, 0), a2, voffA);
            PG8_WAIT_V(8); PG8_WAIT_L(0); PG8_BAR; PG8_MMA(1, 0, At, B0); PG8_MMA(1, 1, At, B1); PG8_BAR; PG8_SCHED;
            PG8_LDB(B0, 1, 0); PG8_LDB(B1, 1, 1); PG8_SCHED; PG8_LDA(At, 1, 0); PG8_STAGE(PG8_SA(0, 1), a2 + hstepA, voffA);
            PG8_WAIT_V(8); PG8_WAIT_L(0); PG8_BAR; PG8_MMA(0, 0, At, B0); PG8_MMA(0, 1, At, B1); PG8_BAR; PG8_SCHED;
            PG8_LDA(At, 1, 1); PG8_STAGE(PG8_SB(1, 0), b3, voffB); PG8_STAGE(PG8_SB(1, 1), b3 + hstepB, voffB); PG8_STAGE(PG8_SA(1, 0), a3, voffA);
            PG8_WAIT_V(8); PG8_WAIT_L(0); PG8_BAR; PG8_MMA(1, 0, At, B0); PG8_MMA(1, 1, At, B1); PG8_BAR; PG8_SCHED;
            } else {
            PG8_LDB(B0, 0, 0); PG8_SCHED; PG8_LDA(At, 0, 0); PG8_STAGE(PG8_SA(1, 1), a1 + hstepA, voffA);
            PG8_WAIT_L(8); PG8_BAR; PG8_WAIT_L(0); PG8_MMA(0, 0, At, B0); PG8_BAR; PG8_SCHED;
            PG8_LDB(B1, 0, 1); PG8_STAGE(PG8_SB(0, 0), b2, voffB);
            PG8_BAR; PG8_WAIT_L(0); PG8_MMA(0, 1, At, B1); PG8_BAR;
            PG8_LDA(At, 0, 1); PG8_STAGE(PG8_SA(0, 0), a2, voffA);
            PG8_BAR; PG8_WAIT_L(0); PG8_MMA(1, 0, At, B0); PG8_BAR; PG8_SCHED;
            PG8_STAGE(PG8_SB(0, 1), b2 + hstepB, voffB);
            PG8_WAIT_V(6); PG8_BAR; PG8_MMA(1, 1, At, B1); PG8_BAR;
            PG8_LDB(B0, 1, 0); PG8_SCHED; PG8_LDA(At, 1, 0); PG8_STAGE(PG8_SA(0, 1), a2 + hstepA, voffA);
            PG8_WAIT_L(8); PG8_BAR; PG8_WAIT_L(0); PG8_MMA(0, 0, At, B0); PG8_BAR; PG8_SCHED;
            PG8_LDB(B1, 1, 1); PG8_STAGE(PG8_SB(1, 0), b3, voffB);
            PG8_BAR; PG8_WAIT_L(0); PG8_MMA(0, 1, At, B1); PG8_BAR;
            PG8_LDA(At, 1, 1); PG8_STAGE(PG8_SA(1, 0), a3, voffA);
            PG8_BAR; PG8_WAIT_L(0); PG8_MMA(1, 0, At, B0); PG8_BAR; PG8_SCHED;
            PG8_STAGE(PG8_SB(1, 1), b3 + hstepB, voffB);
            PG8_WAIT_V(6); PG8_BAR; PG8_MMA(1, 1, At, B1); PG8_BAR;
            }
        }
        if constexpr (ALIGN_EPI) { if (wr == 0) PG8_BAR; }
        if constexpr (!Epi::AFTER_DRAIN) { if constexpr (Sched::KSEG) { if (cur.seg < 2) E.mid(acc, cur, wr, fr); else E(acc, cur, wr, wc, fr, fq); } else E(acc, cur, wr, wc, fr, fq); S.done(cur); }
        if (!has_next) break;
        if (S.fresh(nxt))
#pragma unroll
        for (int a = 0; a < 2; ++a)
#pragma unroll
            for (int b = 0; b < 2; ++b)
#pragma unroll
                for (int m = 0; m < 4; ++m)
#pragma unroll
                    for (int n = 0; n < 2; ++n) acc[a][b][m][n] = (f32x4){0.f, 0.f, 0.f, 0.f};
        cur = nxt; cA = nA; cB = nB; ++ui;
        if constexpr (ALIGN_EPI) { if (wr == 1) PG8_BAR; }
    }
    PG8_WAIT_V(0);
    if constexpr (!ALIGN_EPI) { if (wr == 0) PG8_BAR; }
    PG8_BAR;
    if constexpr (Epi::AFTER_DRAIN) { E.fused(acc, cur, wr, wc, fr, fq, lds, wid, lane); S.done(cur); }
#undef PG8_SA
#undef PG8_SB
#undef PG8_STAGE
#undef PG8_LDA
#undef PG8_LDB
#undef PG8_MMA
#undef PG8_WAIT_V
#undef PG8_WAIT_L
#undef PG8_BAR
#undef PG8_SCHED
}
}

#ifndef MK_ONE_LAUNCH
#define MK_ONE_LAUNCH 1
#endif
constexpr int NWAVES = 8, NT = NWAVES * 64;

constexpr int BATCH = 16, SEQ = 2048, DM = 2048, DEPTH = 4;
constexpr int M = BATCH * SEQ;
constexpr int HD = 128, NH = 8, SHD = 64, SNH = 16, NST = 128, DFF = 5632;
constexpr int DFF_LD = 5696;
constexpr int IN_DIM = 5648, NPROJ = 5632;
constexpr int COL_K = 1024, COL_V = 2048, COL_Z = 3072, COL_XBC = 4096, CONV_DIM = 1536;
constexpr int N_PHASES = 7;

constexpr size_t MiB = 1u << 20;
constexpr size_t WS_CTL = 0;
constexpr size_t ZERO_BYTES = 1 * MiB;
constexpr size_t WS_DT = 4 * MiB;
constexpr size_t WS_WDT = 6 * MiB;
constexpr size_t WS_WIN = 8 * MiB;
constexpr size_t WS_WOUT = 96 * MiB;
constexpr size_t WS_WGU = 128 * MiB;
constexpr size_t WS_WDN = 304 * MiB;
constexpr size_t WS_XB0 = 394 * MiB;
constexpr size_t WS_XB1 = 522 * MiB;
constexpr size_t WS_PROJ = 650 * MiB;
constexpr size_t WS_SSQ = 1006 * MiB;
constexpr size_t SSQ_X0 = 0, SSQ_X1 = (size_t)M * 32 * 4, SSQ_ATT = (size_t)M * 64 * 4, SSQ_SSM = (size_t)M * 72 * 4;
constexpr size_t WS_END = 1020 * MiB;
static_assert(WS_SSQ + (size_t)M * 104 * 4 <= WS_END && WS_DT + (size_t)M * 16 * 4 <= WS_WDT && WS_WDT + (size_t)DEPTH * 16 * DM * 2 <= WS_WIN, "ws map a");
static_assert(WS_WIN + (size_t)DEPTH * NPROJ * DM * 2 <= WS_WOUT && WS_WOUT + (size_t)DEPTH * DM * DM * 2 <= WS_WGU && WS_WGU + (size_t)DEPTH * 2 * DFF * DM * 2 <= WS_WDN, "ws map b");
static_assert(WS_WDN + (size_t)DEPTH * DM * DFF_LD * 2 <= WS_XB0 && WS_XB0 + (size_t)M * DM * 2 <= WS_XB1 && WS_XB1 + (size_t)M * DM * 2 <= WS_PROJ && WS_PROJ + (size_t)M * DFF_LD * 2 <= WS_SSQ, "ws map c");
constexpr int CW_BAR = 4096;
constexpr size_t PROJ_TOFF = (size_t)4096 * (DFF_LD - NPROJ);
static_assert(DFF_LD >= NPROJ, "proj team slices");

constexpr int RING_BYTES = 131072;
constexpr int XCH_OFF = RING_BYTES + 1024;
constexpr int FTAB_OFF = RING_BYTES + 1024;
constexpr int TBL_OFF = RING_BYTES + 9216;
constexpr int GAIN_OFF = TBL_OFF + 4096;
constexpr int MISC_OFF = 147456 - 128;
constexpr int LDS_BYTES = 147456;

#define GAS __attribute__((address_space(1)))
#define LAS __attribute__((address_space(3)))
typedef unsigned short bf16;
typedef unsigned v4u __attribute__((ext_vector_type(4)));
typedef unsigned v2u __attribute__((ext_vector_type(2)));
typedef float f32x4 __attribute__((ext_vector_type(4)));
typedef short bf16x8 __attribute__((ext_vector_type(8)));
typedef GAS unsigned gu32;
#define RLX_AGENT __ATOMIC_RELAXED, __HIP_MEMORY_SCOPE_AGENT
#define LDS_WAIT() asm volatile("s_waitcnt lgkmcnt(0)" ::: "memory")
#define VM_WAIT() asm volatile("s_waitcnt vmcnt(0)" ::: "memory")
__device__ __forceinline__ unsigned f2bf(float f) { unsigned u = __builtin_bit_cast(unsigned, f); return (u + 0x7fffu + ((u >> 16) & 1u)) >> 16; }
__device__ __forceinline__ unsigned pk2(float lo, float hi) { return f2bf(lo) | (f2bf(hi) << 16); }
__device__ __forceinline__ float bflo(unsigned w) { return __builtin_bit_cast(float, w << 16); }
__device__ __forceinline__ float bfhi(unsigned w) { return __builtin_bit_cast(float, w & 0xffff0000u); }
__device__ __forceinline__ float bf1(bf16 h) { return __builtin_bit_cast(float, (unsigned)h << 16); }
__device__ __forceinline__ float wave_sum(float v) {
#pragma unroll
    for (int o = 1; o < 64; o <<= 1) v += __shfl_xor(v, o);
    return v;
}
constexpr float EPS = 1e-6f;
#define XB_TMO      128
#define XB_XCNT(j)  (256  + 64 * (j))
#define XB_XSUB(j)  (1280 + 64 * (j))
#define XB_XGEN(j)  (2304 + 64 * (j))
#define XB_TOP      3328
#define XB_TOPGEN   3392
#define XB_TSUB(j)  (3456 + 64 * (j))
#define XB_TGEN(j)  (3968 + 64 * (j))
#define XB_TMAX(j)  (4480 + 64 * (j))
#define XB_TMIN(j)  (4992 + 64 * (j))
#define XCD_BAR_WORDS 5504
#define XB_SPIN_CAP (1u << 18)

__device__ __forceinline__ unsigned xb_ld(unsigned* p)              { return __hip_atomic_load(p, __ATOMIC_RELAXED, __HIP_MEMORY_SCOPE_AGENT); }
__device__ __forceinline__ unsigned xb_add(unsigned* p, unsigned v) { return __hip_atomic_fetch_add(p, v, __ATOMIC_RELAXED, __HIP_MEMORY_SCOPE_AGENT); }
__device__ __forceinline__ unsigned xb_xcc_id() { return (unsigned)__builtin_amdgcn_s_getreg((3 << 11) | 20) & 0xFu; }
#define XB_SPIN(cond, bar) do { unsigned _sp = 0; while (cond) { __builtin_amdgcn_s_sleep(1); \
    if ((++_sp & 255u) == 0u) { if (xb_ld(&(bar)[XB_TMO])) break; if (_sp > XB_SPIN_CAP) { atomicAdd(&(bar)[XB_TMO], 1u); break; } } } } while (0)

struct XcdBarrier {
    unsigned* bar; unsigned x;
    volatile LAS unsigned* st;
};

__device__ __forceinline__ XcdBarrier xcd_barrier_post(unsigned* bar, volatile LAS unsigned* st) {
    XcdBarrier b; b.bar = bar; b.x = xb_xcc_id(); b.st = st;
    if (threadIdx.x == 0) (void)xb_add(&bar[XB_XCNT(b.x)], 1u);
    return b;
}
__device__ __forceinline__ void xcd_barrier_complete(unsigned* bar, unsigned x, unsigned& nloc, unsigned& nx) {
    const unsigned G = gridDim.x * gridDim.y * gridDim.z;
    unsigned sum, cnt, mine, sp = 0u;
    for (;;) {
        sum = 0u; cnt = 0u; mine = 0u;
#pragma unroll
        for (unsigned j = 0; j < 16; ++j) { const unsigned c = xb_ld(&bar[XB_XCNT(j)]); sum += c; cnt += (c > 0u) ? 1u : 0u; mine = (j == x) ? c : mine; }
        if (sum == G) break;
        __builtin_amdgcn_s_sleep(1);
        if ((++sp & 255u) == 0u) { if (xb_ld(&bar[XB_TMO])) break; if (sp > XB_SPIN_CAP) { atomicAdd(&bar[XB_TMO], 1u); break; } }
    }
    nloc = mine > 0u ? mine : 1u; nx = cnt > 0u ? cnt : 1u;
}

__device__ __forceinline__ void xcd_barrier(const XcdBarrier& b) {
    asm volatile("s_waitcnt vmcnt(0)" ::: "memory");
    __syncthreads();
    if (threadIdx.x == 0) {
        unsigned* bar = b.bar;
        __builtin_amdgcn_s_waitcnt(0);
        unsigned nloc = b.st[0], nx = b.st[1];
        if (nloc == 0u) { xcd_barrier_complete(bar, b.x, nloc, nx); b.st[0] = nloc; b.st[1] = nx; }
        const unsigned old = xb_add(&bar[XB_XSUB(b.x)], 1u);
        const unsigned gen = old / nloc;
        if (old + 1u == (gen + 1u) * nloc) {
            __builtin_amdgcn_fence(__ATOMIC_RELEASE, "agent");
            asm volatile("s_waitcnt vmcnt(0)" ::: "memory");
            const unsigned og = xb_add(&bar[XB_TOP], 1u);
            const unsigned tg = og / nx;
            if (og + 1u == (tg + 1u) * nx) xb_add(&bar[XB_TOPGEN], 1u);
            else XB_SPIN(xb_ld(&bar[XB_TOPGEN]) == tg, bar);
            __builtin_amdgcn_fence(__ATOMIC_ACQUIRE, "agent");
            xb_add(&bar[XB_XGEN(b.x)], 1u);
            asm volatile("s_waitcnt vmcnt(0)" ::: "memory");
        } else {
            XB_SPIN(xb_ld(&bar[XB_XGEN(b.x)]) == gen, bar);
            __builtin_amdgcn_fence(__ATOMIC_ACQUIRE, "agent");
            asm volatile("s_waitcnt vmcnt(0)" ::: "memory");
        }
    }
    __syncthreads();
}

__device__ __forceinline__ void transpose_item(const float* W, int ldw, int k0, int n0, const float* gain, bf16* WT, int ldt, int drow0, LAS float* scr, int lane) {
    float wv_[64];
#pragma unroll
    for (int i = 0; i < 64; ++i) wv_[i] = W[(size_t)(k0 + i) * ldw + n0 + lane];
#pragma unroll
    for (int i = 0; i < 64; ++i) { const float gn = gain ? gain[k0 + i] : 1.0f; scr[i * 65 + lane] = wv_[i] * gn; }
    LDS_WAIT(); asm volatile("" ::: "memory");
    const int c = lane & 7;
#pragma unroll
    for (int j = 0; j < 8; ++j) { const int n = (lane >> 3) + 8 * j; const LAS float* s = scr + (8 * c) * 65 + n;
        v4u o; o.x = pk2(s[0 * 65], s[1 * 65]); o.y = pk2(s[2 * 65], s[3 * 65]); o.z = pk2(s[4 * 65], s[5 * 65]); o.w = pk2(s[6 * 65], s[7 * 65]);
        *(GAS v4u*)(WT + (size_t)(drow0 + n) * ldt + k0 + 8 * c) = o; }
    LDS_WAIT(); asm volatile("" ::: "memory");
}

struct Ptrs {
    const float *x, *norm_mix, *w_in, *q_gain, *k_gain, *conv_w, *conv_b, *dt_bias, *a_log, *d_skip, *attn_gain, *ssm_gain, *w_out, *norm_ffn, *w_gate, *w_up, *w_down;
    float* out; unsigned char* ws;
};

__device__ __forceinline__ void prologue(const Ptrs& P, LAS unsigned char* lds, int vcu, int G, int wave, int lane) {
    LAS float* scr = (LAS float*)(lds + wave * 16640);
    const int gw = vcu * NWAVES + wave, NGW = G * NWAVES;
    bf16* WIN = (bf16*)(P.ws + WS_WIN); bf16* WOUT = (bf16*)(P.ws + WS_WOUT); bf16* WGU = (bf16*)(P.ws + WS_WGU); bf16* WDN = (bf16*)(P.ws + WS_WDN);
    constexpr int I_IN = 32 * 88, I_OUT = 32 * 32, I_G = 32 * 88, I_DN = 88 * 32, I_LAYER = I_IN + I_OUT + 2 * I_G + I_DN;
    for (int it = gw; it < DEPTH * I_LAYER; it += NGW) {
        const int l = it / I_LAYER; int r = it % I_LAYER;
        if (r < I_IN) { const int kb = r / 88, nb = r % 88;
            transpose_item(P.w_in + (size_t)l * DM * IN_DIM, IN_DIM, 64 * kb, 64 * nb, P.norm_mix + l * DM, WIN + (size_t)l * NPROJ * DM, DM, 64 * nb, scr, lane); continue; }
        r -= I_IN;
        if (r < I_OUT) { const int kb = r / 32, nb = r % 32; const int k0 = 64 * kb;
            const float* gain = (k0 < 1024) ? (P.attn_gain + l * 1024) : (P.ssm_gain + l * 1024 - 1024);
            transpose_item(P.w_out + (size_t)l * DM * DM, DM, k0, 64 * nb, gain, WOUT + (size_t)l * DM * DM, DM, 64 * nb, scr, lane); continue; }
        r -= I_OUT;
        if (r < 2 * I_G) { const int up = r / I_G; r -= up * I_G; const int kb = r / 88, nb = r % 88; const int n0 = 64 * nb;
            const float* W = (up ? P.w_up : P.w_gate) + (size_t)l * DM * DFF;
            transpose_item(W, DFF, 64 * kb, n0, P.norm_ffn + l * DM, WGU + (size_t)l * 2 * DFF * DM, DM, 256 * (n0 / 128) + (n0 % 128) + 128 * up, scr, lane); continue; }
        r -= 2 * I_G;
        { const int kb = r / 32, nb = r % 32;
            transpose_item(P.w_down + (size_t)l * DFF * DM, DM, 64 * kb, 64 * nb, nullptr, WDN + (size_t)l * DM * DFF_LD, DFF_LD, 64 * nb, scr, lane); }
    }
    { bf16* WDT = (bf16*)(P.ws + WS_WDT);
      for (int idx = gw * 64 + lane; idx < DEPTH * 16 * DM; idx += NGW * 64) { const int l = idx / (16 * DM), j = (idx / DM) % 16, k = idx % DM;
          WDT[idx] = (bf16)f2bf(P.w_in[(size_t)l * DM * IN_DIM + (size_t)k * IN_DIM + NPROJ + j] * P.norm_mix[l * DM + k]); } }
    { bf16* XB0 = (bf16*)P.out; float* ssq = (float*)(P.ws + WS_SSQ + SSQ_X0);
      for (int row = gw; row < M; row += NGW) {
          const GAS f32x4* xr = (const GAS f32x4*)(P.x + (size_t)row * DM) + lane; GAS v2u* o8 = (GAS v2u*)(XB0 + (size_t)row * DM) + lane;
          float s = 0.f;
#pragma unroll
          for (int j = 0; j < 8; ++j) { const f32x4 v = xr[64 * j]; s += (v.x * v.x + v.y * v.y) + (v.z * v.z + v.w * v.w); v2u w; w.x = pk2(v.x, v.y); w.y = pk2(v.z, v.w); o8[64 * j] = w; }
          s = wave_sum(s);
          if (lane < 32) ssq[(size_t)row * 32 + lane] = (lane == 0) ? s : 0.f; } }
}

__device__ __forceinline__ void dt_pass(const bf16* xb, const bf16* wdt, const float* ssq, float* dtbuf, int vcu, int G, int wave, int lane, LAS unsigned char* lds) {
    constexpr int WPITCH = 2 * DM + 16;
    { const int tid = wave * 64 + lane;
      __syncthreads();
#pragma unroll
      for (int i = 0; i < (16 * DM * 2 / 16) / NT; ++i) { const int n = tid + NT * i, r = n >> 8, c = n & 255;
          *(LAS v4u*)(lds + r * WPITCH + 16 * c) = *(const v4u*)(wdt + (size_t)r * DM + 8 * c); }
      __syncthreads(); }
    const int gw = vcu * NWAVES + wave, NGW = G * NWAVES;
    for (int g = gw; g < M / 16; g += NGW) {
        const int row0 = 16 * g;
        const bf16* ap = xb + (size_t)(row0 + (lane & 15)) * DM + 8 * (lane >> 4);
        const LAS unsigned char* bp = lds + (lane & 15) * WPITCH + 16 * (lane >> 4);
        f32x4 acc = (f32x4){0.f, 0.f, 0.f, 0.f};
#pragma unroll 8
        for (int s = 0; s < DM / 32; ++s) { const bf16x8 a = *(const bf16x8*)(ap + 32 * s), b = *(const LAS bf16x8*)(bp + 64 * s);
            acc = __builtin_amdgcn_mfma_f32_16x16x32_bf16(a, b, acc, 0, 0, 0); }
#pragma unroll
        for (int i = 0; i < 4; ++i) { const int row = row0 + 4 * (lane >> 4) + i; const float rs = pg8::row_rstd(ssq, row, 1.0f / DM);
            dtbuf[(size_t)row * 16 + (lane & 15)] = acc[i] * rs; }
    }
}

namespace att {
typedef bf16x8 bf16x8_t;
typedef float f32x16 __attribute__((ext_vector_type(16)));
typedef short s16x4 __attribute__((ext_vector_type(4)));
constexpr float ATT_STOP = 1e-24f;
constexpr int KBUF0 = 0, VBUF0 = 32768, TILE_BYTES = 16384, FLAGS = 65536;
__device__ __forceinline__ unsigned off_b(unsigned row, unsigned ch) { return 256u * row + 16u * (ch ^ (((row & 3) << 2) | ((row >> 2) & 3))); }
__device__ __forceinline__ unsigned cvtpk(float lo, float hi) { unsigned r; asm volatile("v_cvt_pk_bf16_f32 %0, %1, %2" : "=v"(r) : "v"(lo), "v"(hi)); return r; }

template <bool DIAG> __device__ __forceinline__ void stick_block(const f32x16& sa, float& P, float (&W)[16], int kq, int hh) {
    float rr[16];
#pragma unroll
    for (int r = 0; r < 16; ++r) { const float u = __builtin_amdgcn_exp2f(sa[r]); float r1 = __builtin_amdgcn_rcpf(1.0f + u);
        if (DIAG) { const bool valid = (kq + (r & 3) + 8 * (r >> 2) + 4 * hh) < 0; r1 = valid ? r1 : 1.0f; }
        rr[r] = r1; }
    float Gq[4], Gp[4];
#pragma unroll
    for (int g = 0; g < 4; ++g) { Gq[g] = (rr[4 * g] * rr[4 * g + 1]) * (rr[4 * g + 2] * rr[4 * g + 3]); Gp[g] = __shfl_xor(Gq[g], 32); }
    float T = P;
#pragma unroll
    for (int g = 3; g >= 0; --g) { const float base = T * (hh ? 1.0f : Gp[g]);
        const float e3 = base, e2 = e3 * rr[4 * g + 3], e1 = e2 * rr[4 * g + 2], e0 = e1 * rr[4 * g + 1];
        W[4 * g + 3] = e3 - rr[4 * g + 3] * e3; W[4 * g + 2] = e2 - rr[4 * g + 2] * e2; W[4 * g + 1] = e1 - rr[4 * g + 1] * e1; W[4 * g] = e0 - rr[4 * g] * e0;
        T = T * (Gq[g] * Gp[g]); }
    P = T;
}

#define ATT_LOAD_HEAD(b_, h_, qb_) do { int tz_ = tid; asm volatile("" : "+v"(tz_)); const int ln_ = tz_ & 63, wv_ = __builtin_amdgcn_readfirstlane(tz_ >> 6); \
        const size_t rb_ = (size_t)(b_) * SEQ; const int t0_ = 256 * (qb_); const bf16* pj_ = proj + (size_t)((b_) >> 1) * PROJ_TOFF; \
        const bf16* qp_ = pj_ + (rb_ + t0_ + 32 * wv_ + (ln_ & 31)) * NPROJ + (h_) * HD + 8 * (ln_ >> 5); \
        _Pragma("unroll") for (int ks_ = 0; ks_ < 8; ++ks_) qf[ks_] = *(const bf16x8*)(qp_ + 16 * ks_); \
        const bf16* kp_ = pj_ + (rb_ + (tz_ >> 4) + 64 * (t0_ / 64 + 3)) * NPROJ + COL_K + (h_) * HD + 8 * (tz_ & 15); \
        kr0 = *(const v4u*)kp_; kr1 = *(const v4u*)(kp_ + (size_t)32 * NPROJ); vr0 = *(const v4u*)(kp_ + (COL_V - COL_K)); vr1 = *(const v4u*)(kp_ + (size_t)32 * NPROJ + (COL_V - COL_K)); } while (0)
__device__ __forceinline__ void attn_unit(const bf16* proj, bf16* mix, float* ssq_att, int b, int h, int qb, LAS unsigned char* lds, int tid,
                                          bf16x8 (&qf)[8], v4u& kr0, v4u& kr1, v4u& vr0, v4u& vr1, int nb, int nh, int nqb) {
    const int lane = tid & 63, wave = __builtin_amdgcn_readfirstlane(tid >> 6), qi = lane & 31, hh = lane >> 5;
    const int t0 = 256 * qb, q0 = t0 + 32 * wave;
    const size_t rowbase = (size_t)b * SEQ;
    f32x16 oT[4];
#pragma unroll
    for (int c = 0; c < 4; ++c)
#pragma unroll
        for (int r = 0; r < 16; ++r) oT[c][r] = 0.f;
    float P = 1.0f; bool wdone = false;
    const unsigned kbase = off_b(qi, hh);
    unsigned vbase[2];
    { const unsigned blk = (lane >> 4) & 1, q4 = (lane & 15) >> 2, p = lane & 3;
#pragma unroll
      for (int t = 0; t < 2; ++t) vbase[t] = off_b(8 * t + 4 * hh + q4, 2 * blk + (p >> 1)) + 8 * (p & 1); }
    const int srow = tid >> 4, sch = tid & 15;
    const bf16* kg0 = proj + (size_t)(b >> 1) * PROJ_TOFF + (rowbase + srow) * NPROJ + COL_K + h * HD + 8 * sch;
    const unsigned soff0 = off_b(srow, sch), soff1 = off_b(srow + 32, sch);
    const int nt = t0 / 64 + 4;
    __syncthreads();
    *(LAS v4u*)(lds + KBUF0 + soff0) = kr0; *(LAS v4u*)(lds + KBUF0 + soff1) = kr1; *(LAS v4u*)(lds + VBUF0 + soff0) = vr0; *(LAS v4u*)(lds + VBUF0 + soff1) = vr1;
    __syncthreads();
    for (int it = 0; it < nt; ++it) {
        const int kt = nt - 1 - it, s0 = 64 * kt, buf = it & 1;
        if (it + 1 < nt) { const bf16* kp = kg0 + (size_t)(s0 - 64) * NPROJ;
            kr0 = *(const v4u*)kp; kr1 = *(const v4u*)(kp + (size_t)32 * NPROJ); vr0 = *(const v4u*)(kp + (COL_V - COL_K)); vr1 = *(const v4u*)(kp + (size_t)32 * NPROJ + (COL_V - COL_K)); }
        const LAS unsigned char* kimg = lds + KBUF0 + buf * TILE_BYTES; const LAS unsigned char* vimg = lds + VBUF0 + buf * TILE_BYTES;
#pragma unroll
        for (int blk = 1; blk >= 0; --blk) {
            const int kb0 = s0 + 32 * blk;
            if (kb0 <= q0 + 30 && !wdone) {
                f32x16 sa;
#pragma unroll
                for (int r = 0; r < 16; ++r) sa[r] = 0.f;
#pragma unroll
                for (int ks = 0; ks < 8; ++ks) { const bf16x8 kf = *(const LAS bf16x8*)(kimg + ((kbase ^ (unsigned)(ks << 5)) + 8192u * blk));
                    sa = __builtin_amdgcn_mfma_f32_32x32x16_bf16(kf, qf[ks], sa, 0, 0, 0); }
                s16x4 vlo[4], vhi[4], wlo[4], whi[4];
#pragma unroll
                for (int c = 0; c < 4; ++c) {
                    vlo[c] = __builtin_amdgcn_ds_read_tr16_b64_v4i16((LAS s16x4*)(vimg + ((vbase[0] ^ (unsigned)(c << 6)) + 8192u * blk)));
                    vhi[c] = __builtin_amdgcn_ds_read_tr16_b64_v4i16((LAS s16x4*)(vimg + ((vbase[1] ^ (unsigned)(c << 6)) + 8192u * blk))); }
                __builtin_amdgcn_sched_barrier(0);
                float W[16];
                if (kb0 + 31 >= q0) stick_block<true>(sa, P, W, kb0 - (q0 + qi), hh);
                else stick_block<false>(sa, P, W, 0, hh);
#pragma unroll
                for (int c = 0; c < 4; ++c) {
                    wlo[c] = __builtin_amdgcn_ds_read_tr16_b64_v4i16((LAS s16x4*)(vimg + ((vbase[0] ^ (unsigned)(c << 6)) + 4096u + 8192u * blk)));
                    whi[c] = __builtin_amdgcn_ds_read_tr16_b64_v4i16((LAS s16x4*)(vimg + ((vbase[1] ^ (unsigned)(c << 6)) + 4096u + 8192u * blk))); }
                __builtin_amdgcn_sched_barrier(0);
                { v4u wp; wp.x = cvtpk(W[0], W[1]); wp.y = cvtpk(W[2], W[3]); wp.z = cvtpk(W[4], W[5]); wp.w = cvtpk(W[6], W[7]);
                  const bf16x8 wf = __builtin_bit_cast(bf16x8, wp);
#pragma unroll
                  for (int c = 0; c < 4; ++c) oT[c] = __builtin_amdgcn_mfma_f32_32x32x16_bf16(__builtin_shufflevector(vlo[c], vhi[c], 0, 1, 2, 3, 4, 5, 6, 7), wf, oT[c], 0, 0, 0); }
                { v4u wp; wp.x = cvtpk(W[8], W[9]); wp.y = cvtpk(W[10], W[11]); wp.z = cvtpk(W[12], W[13]); wp.w = cvtpk(W[14], W[15]);
                  const bf16x8 wf = __builtin_bit_cast(bf16x8, wp);
#pragma unroll
                  for (int c = 0; c < 4; ++c) oT[c] = __builtin_amdgcn_mfma_f32_32x32x16_bf16(__builtin_shufflevector(wlo[c], whi[c], 0, 1, 2, 3, 4, 5, 6, 7), wf, oT[c], 0, 0, 0); }
            }
        }
        { wdone = __all(P < ATT_STOP); if (lane == 0) ((LAS unsigned*)(lds + FLAGS))[(it & 1) * 8 + wave] = wdone ? 1u : 0u; }
        if (it + 1 < nt) { const unsigned nb = (buf ^ 1) * TILE_BYTES;
            *(LAS v4u*)(lds + KBUF0 + nb + soff0) = kr0; *(LAS v4u*)(lds + KBUF0 + nb + soff1) = kr1; *(LAS v4u*)(lds + VBUF0 + nb + soff0) = vr0; *(LAS v4u*)(lds + VBUF0 + nb + soff1) = vr1; }
        __syncthreads();
        { const LAS v4u* fl = (const LAS v4u*)(lds + FLAGS + (it & 1) * 32); const v4u a = fl[0], c2 = fl[1];
          if ((a.x & a.y & a.z & a.w & c2.x & c2.y & c2.z & c2.w) != 0u) break; }
    }
    ATT_LOAD_HEAD(nb, nh, nqb);
    { float ss = 0.f;
#pragma unroll
      for (int c = 0; c < 4; ++c)
#pragma unroll
          for (int r = 0; r < 16; ++r) ss += oT[c][r] * oT[c][r];
      ss += __shfl_xor(ss, 32);
      const size_t row = rowbase + q0 + qi;
      if (hh == 0) ssq_att[row * 8 + h] = ss;
      bf16* op = mix + row * DM + h * HD + 8 * hh;
#pragma unroll
      for (int c = 0; c < 4; ++c)
#pragma unroll
          for (int g = 0; g < 4; g += 2) {
              const auto rx = __builtin_amdgcn_permlane32_swap(cvtpk(oT[c][4 * g], oT[c][4 * g + 1]), cvtpk(oT[c][4 * g + 4], oT[c][4 * g + 5]), false, false);
              const auto ry = __builtin_amdgcn_permlane32_swap(cvtpk(oT[c][4 * g + 2], oT[c][4 * g + 3]), cvtpk(oT[c][4 * g + 6], oT[c][4 * g + 7]), false, false);
              v4u w; w.x = rx[0]; w.y = ry[0]; w.z = rx[1]; w.w = ry[1]; *(v4u*)(op + 32 * c + 8 * g) = w; } }
}
}

namespace ssd {
using att::f32x16; using att::s16x4; using att::off_b; using att::cvtpk;
constexpr int IMG = 16384, C_IMG = 0, B_IMG = 2 * IMG, X_IMG = 4 * IMG, H_IMG = 6 * IMG;
constexpr int SC_OFF = RING_BYTES + 1024;
constexpr int NCH = SEQ / 64, CSW = CONV_DIM;
__device__ __forceinline__ float wave_incl_scan(float v) {
#define SSD_DPP_ADD(ctrl, rmask) do { const float t_ = __builtin_bit_cast(float, __builtin_amdgcn_update_dpp(0, __builtin_bit_cast(int, v), (ctrl), (rmask), 0xf, true)); v += t_; } while (0)
    SSD_DPP_ADD(0x111, 0xf); SSD_DPP_ADD(0x112, 0xf); SSD_DPP_ADD(0x114, 0xf); SSD_DPP_ADD(0x118, 0xf);
    SSD_DPP_ADD(0x142, 0xa);
    SSD_DPP_ADD(0x143, 0xc);
#undef SSD_DPP_ADD
    return v;
}
__device__ __forceinline__ float softplus_f(float v) { const float e = __expf(v); return v > 20.f ? v : (e < 0.015625f ? e * (1.0f - e * (0.5f - e * (0.33333334f - 0.25f * e))) : __logf(1.0f + e)); }
#define SSD_BAR() do { asm volatile("s_waitcnt lgkmcnt(0)" ::: "memory"); __builtin_amdgcn_s_barrier(); asm volatile("" ::: "memory"); } while (0)

__device__ __forceinline__ void conv_prepass(const bf16* proj, bf16* cs, const float* conv_w, const float* conv_b, int vcu, int G, int tid, LAS unsigned char* lds) {
    constexpr int NIT_ALL = (M / 8) * (CSW / 8), NIT_TEAM = NIT_ALL / 8;
    const bool teams = (G == 256);
    const int gt = teams ? (vcu >> 5) * NIT_TEAM + (vcu & 31) * NT + tid : vcu * NT + tid, NGT = teams ? 32 * NT : G * NT, NIT = teams ? ((vcu >> 5) + 1) * NIT_TEAM : NIT_ALL;
    LAS float* wl = (LAS float*)lds;
    __syncthreads();
    for (int i = tid; i < 5 * CONV_DIM / 4; i += NT) ((LAS f32x4*)wl)[i] = (i < CONV_DIM) ? ((const f32x4*)conv_w)[i] : ((const f32x4*)conv_b)[i - CONV_DIM];
    __syncthreads();
    v4u nraw[11];
#define CP_LOAD(it_) do { const int ch_ = (it_) % (CSW / 8), rb_ = (it_) / (CSW / 8); const int row0_ = 8 * rb_, t0_ = row0_ % SEQ; const bf16* src_ = proj + (size_t)row0_ * NPROJ + (size_t)(row0_ >> 12) * PROJ_TOFF + COL_XBC + 8 * ch_; \
        _Pragma("unroll") for (int i_ = 0; i_ < 11; ++i_) { if (t0_ - 3 + i_ >= 0) nraw[i_] = *(const v4u*)(src_ + (ptrdiff_t)(i_ - 3) * NPROJ); else { nraw[i_].x = 0u; nraw[i_].y = 0u; nraw[i_].z = 0u; nraw[i_].w = 0u; } } } while (0)
    if (gt < NIT) CP_LOAD(gt);
    for (int it = gt; it < NIT; it += NGT) {
        const int ch = it % (CSW / 8), rb = it / (CSW / 8); const int row0 = 8 * rb;
        v4u raw[11];
#pragma unroll
        for (int i = 0; i < 11; ++i) raw[i] = nraw[i];
        float cw[4][8], cb[8];
        { const f32x4 b0 = *(const LAS f32x4*)(wl + 4 * CONV_DIM + 8 * ch), b1 = *(const LAS f32x4*)(wl + 4 * CONV_DIM + 8 * ch + 4);
#pragma unroll
          for (int j = 0; j < 4; ++j) { cb[j] = b0[j]; cb[4 + j] = b1[j]; }
#pragma unroll
          for (int k = 0; k < 4; ++k) { const f32x4 w0 = *(const LAS f32x4*)(wl + k * CONV_DIM + 8 * ch), w1 = *(const LAS f32x4*)(wl + k * CONV_DIM + 8 * ch + 4);
#pragma unroll
              for (int j = 0; j < 4; ++j) { cw[k][j] = w0[j]; cw[k][4 + j] = w1[j]; } } }
        if (it + NGT < NIT) CP_LOAD(it + NGT);
#pragma unroll
        for (int i = 0; i < 8; ++i) { float o[8];
#pragma unroll
            for (int j = 0; j < 8; ++j) o[j] = cb[j];
#pragma unroll
            for (int k = 0; k < 4; ++k) { const v4u u = raw[i + k];
                o[0] += cw[k][0] * bflo(u.x); o[1] += cw[k][1] * bfhi(u.x); o[2] += cw[k][2] * bflo(u.y); o[3] += cw[k][3] * bfhi(u.y);
                o[4] += cw[k][4] * bflo(u.z); o[5] += cw[k][5] * bfhi(u.z); o[6] += cw[k][6] * bflo(u.w); o[7] += cw[k][7] * bfhi(u.w); }
#pragma unroll
            for (int j = 0; j < 8; ++j) o[j] = o[j] * __builtin_amdgcn_rcpf(1.0f + __expf(-o[j]));
            v4u w; w.x = cvtpk(o[0], o[1]); w.y = cvtpk(o[2], o[3]); w.z = cvtpk(o[4], o[5]); w.w = cvtpk(o[6], o[7]);
            *(v4u*)(cs + (size_t)(row0 + i) * CSW + 8 * ch) = w; }
    }
#undef CP_LOAD
}

__device__ __forceinline__ void ssd_unit(const bf16* proj, const bf16* cs, const float* dtbuf, bf16* mix, float* ssq_ssm  , float dtb, float a, float Dh,
                                         int b, int head, LAS unsigned char* lds, int tid) {
    const int lane = tid & 63, wave = __builtin_amdgcn_readfirstlane(tid >> 6), g = head >> 3;
    const size_t rowbase = (size_t)b * SEQ;
    LAS float* dtv = (LAS float*)(lds + SC_OFF); LAS float* acm = dtv + 128; LAS float* wvv = dtv + 256;
    __syncthreads();
    { v4u z4; z4.x = 0u; z4.y = 0u; z4.z = 0u; z4.w = 0u; *(LAS v4u*)(lds + H_IMG + tid * 32) = z4; *(LAS v4u*)(lds + H_IMG + tid * 32 + 16) = z4; }
    if (wave >= 6) {
        v4u rgA[20], rgB[20]; float dtA = 0.f, dtB = 0.f;
#define SSD_LOAD(rg, dtraw, cn) do { int lz_ = lane; asm volatile("" : "+v"(lz_)); const int cn_ = (cn) < NCH ? (cn) : NCH - 1; const bf16* base_ = cs + (rowbase + 64 * cn_) * CSW; \
        if (wave == 6) { _Pragma("unroll") for (int k_ = 0; k_ < 16; ++k_) rg[k_] = *(const v4u*)(base_ + (size_t)((lz_ >> 4) + 4 * k_) * CSW + 1280 + 128 * g + 8 * (lz_ & 15)); \
                         _Pragma("unroll") for (int k_ = 0; k_ < 4; ++k_) rg[16 + k_] = *(const v4u*)(base_ + (size_t)((lz_ >> 3) + 8 * k_) * CSW + 64 * head + 8 * (lz_ & 7)); } \
        else { _Pragma("unroll") for (int k_ = 0; k_ < 16; ++k_) rg[k_] = *(const v4u*)(base_ + (size_t)((lz_ >> 4) + 4 * k_) * CSW + 1024 + 128 * g + 8 * (lz_ & 15)); \
               _Pragma("unroll") for (int k_ = 4; k_ < 8; ++k_) rg[12 + k_] = *(const v4u*)(base_ + (size_t)((lz_ >> 3) + 8 * k_) * CSW + 64 * head + 8 * (lz_ & 7)); } \
        dtraw = dtbuf[(rowbase + 64 * cn_ + lz_) * 16 + head]; } while (0)        \

#define SSD_PUT(rg, dtraw, buf) do { int lz_ = lane; asm volatile("" : "+v"(lz_)); \
        if (wave == 6) { _Pragma("unroll") for (int k_ = 0; k_ < 16; ++k_) *(LAS v4u*)(lds + C_IMG + (buf) * IMG + off_b((lz_ >> 4) + 4 * k_, lz_ & 15)) = rg[k_]; \
                         _Pragma("unroll") for (int k_ = 0; k_ < 4; ++k_) *(LAS v4u*)(lds + X_IMG + (buf) * IMG + off_b((lz_ >> 3) + 8 * k_, lz_ & 7)) = rg[16 + k_]; } \
        else { _Pragma("unroll") for (int k_ = 0; k_ < 16; ++k_) *(LAS v4u*)(lds + B_IMG + (buf) * IMG + off_b((lz_ >> 4) + 4 * k_, lz_ & 15)) = rg[k_]; \
               _Pragma("unroll") for (int k_ = 4; k_ < 8; ++k_) *(LAS v4u*)(lds + X_IMG + (buf) * IMG + off_b((lz_ >> 3) + 8 * k_, lz_ & 7)) = rg[12 + k_]; \
               const float dt_ = softplus_f(dtraw + dtb); float ac_ = dt_ * a; \
               ac_ = wave_incl_scan(ac_); \
               const float tot_ = __builtin_bit_cast(float, __builtin_amdgcn_readlane(__builtin_bit_cast(int, ac_), 63)); dtv[(buf) * 64 + lane] = ac_ * 1.44269504f - __log2f(dt_); acm[(buf) * 64 + lane] = ac_; wvv[(buf) * 64 + lane] = dt_ * __expf(tot_ - ac_); } } while (0)
        SSD_LOAD(rgA, dtA, 0); SSD_LOAD(rgB, dtB, 1); SSD_PUT(rgA, dtA, 0); SSD_LOAD(rgA, dtA, 2);
        SSD_BAR();
        for (int c = 0; c < NCH; c += 2) {
            SSD_PUT(rgB, dtB, (c + 1) & 1); SSD_LOAD(rgB, dtB, c + 3);
            SSD_BAR();
            SSD_PUT(rgA, dtA, (c + 2) & 1); SSD_LOAD(rgA, dtA, c + 4);
            SSD_BAR();
        }
#undef SSD_LOAD
#undef SSD_PUT
    } else if (wave < 4) {
        const int lb = wave & 1, pb = wave >> 1;
        v2u zn[4];
        { int lz0 = lane; asm volatile("" : "+v"(lz0));
          const bf16* zp = proj + (rowbase + 32 * lb + (lz0 & 31)) * NPROJ + COL_Z + 64 * head + 32 * pb + 4 * (lz0 >> 5);
#pragma unroll
          for (int g4 = 0; g4 < 4; ++g4) zn[g4] = *(const v2u*)(zp + 8 * g4); }
        SSD_BAR();
        for (int c = 0; c < NCH; ++c) {
            int lz = lane; asm volatile("" : "+v"(lz));
            const int qi = lz & 31, hh = lz >> 5, l = 32 * lb + qi;
            const unsigned kbase = off_b(qi, hh);
            unsigned vbase[2], nbase[2];
            { const unsigned blk = (lz >> 4) & 1, q4 = (lz & 15) >> 2, p = lz & 3;
#pragma unroll
              for (int t = 0; t < 2; ++t) { vbase[t] = off_b(8 * t + 4 * hh + q4, 2 * blk + (p >> 1)) + 8 * (p & 1); nbase[t] = off_b(8 * hh + 4 * t + q4, 2 * blk + (p >> 1)) + 8 * (p & 1); } }
            const int cur = c & 1; const size_t row = rowbase + 64 * c + l;
            const LAS unsigned char* Cim = lds + C_IMG + cur * IMG; const LAS unsigned char* Bim = lds + B_IMG + cur * IMG; const LAS unsigned char* Xim = lds + X_IMG + cur * IMG; const LAS unsigned char* Him = lds + H_IMG + cur * IMG;
            v2u zr[4];
#pragma unroll
            for (int g4 = 0; g4 < 4; ++g4) zr[g4] = zn[g4];
            if (c + 1 < NCH) {
#pragma unroll
                for (int g4 = 0; g4 < 4; ++g4) zn[g4] = *(const v2u*)(proj + (row + 64) * NPROJ + COL_Z + 64 * head + 32 * pb + 8 * g4 + 4 * hh); }
            bf16x8 cf[8];
#pragma unroll
            for (int ks = 0; ks < 8; ++ks) cf[ks] = *(const LAS bf16x8*)(Cim + ((kbase ^ (unsigned)(ks << 5)) + 8192u * lb));
            f32x16 y, y2;
#pragma unroll
            for (int r = 0; r < 16; ++r) { y[r] = 0.f; y2[r] = 0.f; }
#pragma unroll
            for (int ks = 0; ks < 4; ++ks) {
                const s16x4 h0 = __builtin_amdgcn_ds_read_tr16_b64_v4i16((LAS s16x4*)(Him + ((nbase[0] ^ (unsigned)(pb << 6)) + 4096u * ks)));
                const s16x4 h1 = __builtin_amdgcn_ds_read_tr16_b64_v4i16((LAS s16x4*)(Him + ((nbase[1] ^ (unsigned)(pb << 6)) + 4096u * ks)));
                const s16x4 h2 = __builtin_amdgcn_ds_read_tr16_b64_v4i16((LAS s16x4*)(Him + ((nbase[0] ^ (unsigned)((2 + pb) << 6)) + 4096u * ks)));
                const s16x4 h3 = __builtin_amdgcn_ds_read_tr16_b64_v4i16((LAS s16x4*)(Him + ((nbase[1] ^ (unsigned)((2 + pb) << 6)) + 4096u * ks)));
                y = __builtin_amdgcn_mfma_f32_32x32x16_bf16(__builtin_shufflevector(h0, h1, 0, 1, 2, 3, 4, 5, 6, 7), cf[ks], y, 0, 0, 0);
                y2 = __builtin_amdgcn_mfma_f32_32x32x16_bf16(__builtin_shufflevector(h2, h3, 0, 1, 2, 3, 4, 5, 6, 7), cf[4 + ks], y2, 0, 0, 0); }
            const float al = acm[cur * 64 + l]; const float el = __expf(al), al2 = al * 1.44269504f;
#pragma unroll
            for (int r = 0; r < 16; ++r) y[r] = (y[r] + y2[r]) * el;
#pragma unroll
            for (int sb = 0; sb < 2; ++sb) {
                if (sb <= lb) {
                    f32x16 ga, gb;
#pragma unroll
                    for (int r = 0; r < 16; ++r) { ga[r] = 0.f; gb[r] = 0.f; }
#pragma unroll
                    for (int ks = 0; ks < 8; ks += 2) { const bf16x8 b0 = *(const LAS bf16x8*)(Bim + ((kbase ^ (unsigned)(ks << 5)) + 8192u * sb)), b1 = *(const LAS bf16x8*)(Bim + ((kbase ^ (unsigned)((ks + 1) << 5)) + 8192u * sb));
                        ga = __builtin_amdgcn_mfma_f32_32x32x16_bf16(b0, cf[ks], ga, 0, 0, 0); gb = __builtin_amdgcn_mfma_f32_32x32x16_bf16(b1, cf[ks + 1], gb, 0, 0, 0); }
#pragma unroll
                    for (int r = 0; r < 16; ++r) ga[r] += gb[r];
                    float W[16];
#pragma unroll
                    for (int g4 = 0; g4 < 4; ++g4) { const int sq = 32 * sb + 8 * g4 + 4 * hh; const f32x4 as4 = *(const LAS f32x4*)(dtv + cur * 64 + sq);
#pragma unroll
                        for (int i = 0; i < 4; ++i) { float m = ga[4 * g4 + i] * __builtin_amdgcn_exp2f(al2 - as4[i]); if (sb == lb) m = (sq + i <= l) ? m : 0.f; W[4 * g4 + i] = m; } }
#pragma unroll
                    for (int s2 = 0; s2 < 2; ++s2) {
                        v4u wp; wp.x = cvtpk(W[8 * s2], W[8 * s2 + 1]); wp.y = cvtpk(W[8 * s2 + 2], W[8 * s2 + 3]); wp.z = cvtpk(W[8 * s2 + 4], W[8 * s2 + 5]); wp.w = cvtpk(W[8 * s2 + 6], W[8 * s2 + 7]);
                        const bf16x8 wf = __builtin_bit_cast(bf16x8, wp);
                        const s16x4 lo = __builtin_amdgcn_ds_read_tr16_b64_v4i16((LAS s16x4*)(Xim + ((vbase[0] ^ (unsigned)(pb << 6)) + 4096u * s2 + 8192u * sb)));
                        const s16x4 hi = __builtin_amdgcn_ds_read_tr16_b64_v4i16((LAS s16x4*)(Xim + ((vbase[1] ^ (unsigned)(pb << 6)) + 4096u * s2 + 8192u * sb)));
                        const bf16x8 xf = __builtin_shufflevector(lo, hi, 0, 1, 2, 3, 4, 5, 6, 7);
                        y = __builtin_amdgcn_mfma_f32_32x32x16_bf16(xf, wf, y, 0, 0, 0); }
                }
            }
            { float ss = 0.f; bf16* op = mix + row * DM + 1024 + 64 * head + 32 * pb + 8 * hh; v2u wq[4];
#pragma unroll
              for (int g4 = 0; g4 < 4; ++g4) { const v2u xw = *(const LAS v2u*)(Xim + off_b(l, 4 * pb + g4) + 8 * hh);
                  const float xv[4] = {bflo(xw.x), bfhi(xw.x), bflo(xw.y), bfhi(xw.y)}, zv[4] = {bflo(zr[g4].x), bfhi(zr[g4].x), bflo(zr[g4].y), bfhi(zr[g4].y)};
                  float o[4];
#pragma unroll
                  for (int i = 0; i < 4; ++i) { o[i] = (y[4 * g4 + i] + Dh * xv[i]) * zv[i]; ss += o[i] * o[i]; }
                  wq[g4].x = cvtpk(o[0], o[1]); wq[g4].y = cvtpk(o[2], o[3]); }
#pragma unroll
              for (int g4 = 0; g4 < 4; g4 += 2) {
                  const auto rx = __builtin_amdgcn_permlane32_swap(wq[g4].x, wq[g4 + 1].x, false, false); const auto ry = __builtin_amdgcn_permlane32_swap(wq[g4].y, wq[g4 + 1].y, false, false);
                  v4u w; w.x = rx[0]; w.y = ry[0]; w.z = rx[1]; w.w = ry[1]; *(v4u*)(op + 8 * g4) = w; }
              ss += __shfl_xor(ss, 32);
              if (hh == 0) ssq_ssm[row * 32 + head * 2 + pb] = ss; }
            SSD_BAR();
        }
    } else {
        const int pbh = wave - 4;
        f32x16 hacc[4];
#pragma unroll
        for (int j = 0; j < 4; ++j)
#pragma unroll
            for (int r = 0; r < 16; ++r) hacc[j][r] = 0.f;
        SSD_BAR();
        for (int c = 0; c < NCH; ++c) {
            int lz = lane; asm volatile("" : "+v"(lz));
            const int qi = lz & 31, hh = lz >> 5;
            unsigned nbase[2];
            { const unsigned blk = (lz >> 4) & 1, q4 = (lz & 15) >> 2, p = lz & 3;
#pragma unroll
              for (int t = 0; t < 2; ++t) nbase[t] = off_b(8 * hh + 4 * t + q4, 2 * blk + (p >> 1)) + 8 * (p & 1); }
            const int cur = c & 1, nxt = cur ^ 1;
            const LAS unsigned char* Bim = lds + B_IMG + cur * IMG; const LAS unsigned char* Xim = lds + X_IMG + cur * IMG; LAS unsigned char* Hn = lds + H_IMG + nxt * IMG;
            const float eA = __expf(acm[cur * 64 + 63]);
#pragma unroll
            for (int j = 0; j < 4; ++j)
#pragma unroll
                for (int r = 0; r < 16; ++r) hacc[j][r] *= eA;
#pragma unroll
            for (int k4 = 0; k4 < 4; ++k4) {
                const s16x4 xl = __builtin_amdgcn_ds_read_tr16_b64_v4i16((LAS s16x4*)(Xim + ((nbase[0] ^ (unsigned)(pbh << 6)) + 4096u * k4)));
                const s16x4 xh = __builtin_amdgcn_ds_read_tr16_b64_v4i16((LAS s16x4*)(Xim + ((nbase[1] ^ (unsigned)(pbh << 6)) + 4096u * k4)));
                const f32x4 w0 = *(const LAS f32x4*)(wvv + cur * 64 + 16 * k4 + 8 * hh), w1 = *(const LAS f32x4*)(wvv + cur * 64 + 16 * k4 + 8 * hh + 4);
                v4u xp; xp.x = cvtpk(bf1((bf16)xl[0]) * w0[0], bf1((bf16)xl[1]) * w0[1]); xp.y = cvtpk(bf1((bf16)xl[2]) * w0[2], bf1((bf16)xl[3]) * w0[3]);
                        xp.z = cvtpk(bf1((bf16)xh[0]) * w1[0], bf1((bf16)xh[1]) * w1[1]); xp.w = cvtpk(bf1((bf16)xh[2]) * w1[2], bf1((bf16)xh[3]) * w1[3]);
                const bf16x8 xa = __builtin_bit_cast(bf16x8, xp);
#pragma unroll
                for (int j = 0; j < 4; ++j) {
                    const s16x4 bl = __builtin_amdgcn_ds_read_tr16_b64_v4i16((LAS s16x4*)(Bim + ((nbase[0] ^ (unsigned)(j << 6)) + 4096u * k4)));
                    const s16x4 bh = __builtin_amdgcn_ds_read_tr16_b64_v4i16((LAS s16x4*)(Bim + ((nbase[1] ^ (unsigned)(j << 6)) + 4096u * k4)));
                    const bf16x8 bb = __builtin_shufflevector(bl, bh, 0, 1, 2, 3, 4, 5, 6, 7);
                    hacc[j] = __builtin_amdgcn_mfma_f32_32x32x16_bf16(xa, bb, hacc[j], 0, 0, 0); } }
            if (c + 1 < NCH) {
                const unsigned x16 = 16u * ((((unsigned)qi & 3u) << 2) | (((unsigned)qi >> 2) & 3u));
#pragma unroll
                for (int j = 0; j < 4; ++j)
#pragma unroll
                    for (int g4 = 0; g4 < 4; ++g4) { v2u w; w.x = cvtpk(hacc[j][4 * g4], hacc[j][4 * g4 + 1]); w.y = cvtpk(hacc[j][4 * g4 + 2], hacc[j][4 * g4 + 3]);
                        *(LAS v2u*)(Hn + 256u * (32 * (j & 1) + qi) + ((16u * (unsigned)(8 * (j >> 1) + 4 * pbh + g4)) ^ x16) + 8u * hh) = w; } }
            SSD_BAR();
        }
    }
}
#undef SSD_BAR
}

struct Args { const float* in[17]; float* out; unsigned char* ws; int l_lo, l_hi, ph_lo, ph_hi, do_pro, use_bar, pad0, pad1; };
typedef const Args __attribute__((address_space(4))) CArgs;
__device__ __forceinline__ CArgs* kargs() { CArgs* p = (CArgs*)__builtin_amdgcn_kernarg_segment_ptr(); asm volatile("" : "+s"(p)); return p; }
__device__ __forceinline__ int tid_of(int wave_id) { int t = threadIdx.x; asm volatile("" : "+v"(t)); return t; }
__device__ __forceinline__ int vcu_of(int bx, int G) { return (G % 8 == 0) ? (bx % 8) * (G / 8) + bx / 8 : bx; }
__device__ __forceinline__ void grid_bar(LAS unsigned char* lds) {
    CArgs* A = kargs(); if (!A->use_bar) return;
    XcdBarrier b; b.bar = (unsigned*)(A->ws + WS_CTL) + CW_BAR; b.x = xb_xcc_id(); b.st = (volatile LAS unsigned*)(lds + MISC_OFF) + 8;
    xcd_barrier(b);
}
__device__ __forceinline__ void team_setup(LAS unsigned char* lds) {
    CArgs* A = kargs(); if (!A->use_bar) return;
    volatile LAS unsigned* st = (volatile LAS unsigned*)(lds + MISC_OFF) + 8;
    if (threadIdx.x == 0) { unsigned* bar = (unsigned*)(A->ws + WS_CTL) + CW_BAR; bool fast = (gridDim.x == 256u) && A->do_pro;
#pragma unroll
        for (unsigned t = 0; t < 8; ++t) { const unsigned mx = xb_ld(&bar[XB_TMAX(t)]), mn = xb_ld(&bar[XB_TMIN(t)]); fast = fast && mx != 0u && (mx + mn == 17u); }
        st[2] = fast ? 1u : 2u; }
    __syncthreads();
}
__device__ __forceinline__ void team_bar(LAS unsigned char* lds) {
    CArgs* A = kargs(); if (!A->use_bar) return;
    volatile LAS unsigned* st = (volatile LAS unsigned*)(lds + MISC_OFF) + 8;
    if (st[2] != 1u) { grid_bar(lds); return; }
    asm volatile("s_waitcnt vmcnt(0)" ::: "memory");
    __syncthreads();
    if (threadIdx.x == 0) {
        unsigned* bar = (unsigned*)(A->ws + WS_CTL) + CW_BAR; const unsigned team = blockIdx.x & 7u, nteam = gridDim.x >> 3;
        __builtin_amdgcn_s_waitcnt(0);
        const unsigned old = xb_add(&bar[XB_TSUB(team)], 1u);
        const unsigned gen = old / nteam;
        if (old + 1u == (gen + 1u) * nteam) xb_add(&bar[XB_TGEN(team)], 1u);
        else XB_SPIN(xb_ld(&bar[XB_TGEN(team)]) == gen, bar);
        __builtin_amdgcn_fence(__ATOMIC_ACQUIRE, "agent");
        asm volatile("s_waitcnt vmcnt(0)" ::: "memory");
    }
    __syncthreads();
}
__device__ __forceinline__ int build_rstd_tbl(const float* ssq, LAS float* tbl, int N_, int tid) {
    pg8::StaticOrder S; S.init(M, N_, (int)gridDim.x, (int)blockIdx.x); pg8::Unit u0;
    if (!S.next(0, u0)) return 0;
    const int gid0 = u0.pm >> 3, pmlo = u0.pm & 7; bool ok = true;
    for (int i = 1;; ++i) { pg8::Unit u; if (!S.next(i, u)) break; ok = ok && ((u.pm & 7) == pmlo) && ((u.pm >> 3) >= gid0) && ((u.pm >> 3) < gid0 + 4); }
    const int r = tid >> 1, half = tid & 1;
#pragma unroll
    for (int slot = 0; slot < 4; ++slot) { const int pm = (gid0 + slot) * 8 + pmlo;
        if (pm < M / 256) { const f32x4* p = (const f32x4*)(ssq + ((size_t)pm * 256 + r) * 32 + 16 * half); float sm = 0.f;
#pragma unroll
            for (int i = 0; i < 4; ++i) { const f32x4 v = p[i]; sm += (v[0] + v[1]) + (v[2] + v[3]); }
            sm += __shfl_xor(sm, 1);
            if (half == 0) tbl[slot * 256 + r] = ok ? 1.0f / sqrtf(sm * (1.0f / DM) + EPS) : __builtin_nanf(""); } }
    return gid0;
}
#ifndef RESID_WGM
#define RESID_WGM 4
#endif
__device__ __forceinline__ void build_mix_tbl(const float* ssq_att, const float* ssq_ssm, LAS float* ftab, int tid) {
    pg8::StaticOrder S; S.init(M, DM, (int)gridDim.x, (int)blockIdx.x, RESID_WGM);
    unsigned used = 0u; bool ok = true;
    const int r = tid >> 1, half = tid & 1;
    for (int i = 0;; ++i) { pg8::Unit u; if (!S.next(i, u)) break;
        const int slot = (u.pm >> 2) & 3; ok = ok && !((used >> slot) & 1u) && i < 4; used |= 1u << slot;
        const size_t row = (size_t)u.pm * 256 + r;
        const f32x4* ps = (const f32x4*)(ssq_ssm + row * 32 + 16 * half); float sg = 0.f;
#pragma unroll
        for (int k = 0; k < 4; ++k) { const f32x4 v = ps[k]; sg += (v[0] + v[1]) + (v[2] + v[3]); }
        const f32x4* pa = (const f32x4*)(ssq_att + row * 8); const f32x4 a0 = pa[0], a1 = pa[1];
        const float sa = ((a0[0] + a0[1]) + (a0[2] + a0[3])) + ((a1[0] + a1[1]) + (a1[2] + a1[3]));
        const float rg = 1.0f / sqrtf(sg * (1.0f / 512.f) + EPS), ra = 1.0f / sqrtf(sa * (1.0f / 1024.f) + EPS);
        const float rg_other = __shfl_xor(rg, 1);
        if (half == 0) { const float qn = __builtin_nanf("");
            ftab[slot * 768 + r] = ok ? ra / rg : qn; ftab[slot * 768 + 256 + r] = ok ? rg / rg_other : qn; ftab[slot * 768 + 512 + r] = ok ? rg_other : qn; } }
}
#ifndef PH_MASK
#define PH_MASK 0xFF
#endif
#define IN(k) (((PH_MASK >> (k)) & 1) && kargs()->ph_lo <= (k) && (k) < kargs()->ph_hi)
#ifndef PROBE_DUP
#define PROBE_DUP 0
#endif
#define REPS(k) for (int rep_ = 0; rep_ < (((PROBE_DUP) >> (k)) & 1) + 1; ++rep_)

__global__ void __launch_bounds__(NT, 2) mk_fwd(Args args) {
    extern __shared__ __attribute__((aligned(16))) unsigned char lds_raw[];
    LAS unsigned char* lds = (LAS unsigned char*)lds_raw;
    const int wv = __builtin_amdgcn_readfirstlane(threadIdx.x >> 6);
    { const int tid = threadIdx.x;
      for (int u = tid; u < (LDS_BYTES - RING_BYTES) / 4; u += NT) ((LAS unsigned*)(lds + RING_BYTES))[u] = 0u;
      __syncthreads();
      if (args.use_bar) { unsigned* bar = (unsigned*)(args.ws + WS_CTL) + CW_BAR; (void)xcd_barrier_post(bar, (volatile LAS unsigned*)(lds + MISC_OFF) + 8);
          if (tid == 0) { const unsigned xcc = xb_xcc_id(), team = blockIdx.x & 7u;
              (void)__hip_atomic_fetch_max(&bar[XB_TMAX(team)], xcc + 1u, __ATOMIC_RELAXED, __HIP_MEMORY_SCOPE_AGENT);
              (void)__hip_atomic_fetch_max(&bar[XB_TMIN(team)], 16u - xcc, __ATOMIC_RELAXED, __HIP_MEMORY_SCOPE_AGENT); } } }

    if ((PH_MASK & 1) && kargs()->do_pro) {
        CArgs* A = kargs(); const int tid = tid_of(wv), lane = tid & 63, wave = __builtin_amdgcn_readfirstlane(tid >> 6); const int G = gridDim.x, vcu = vcu_of(blockIdx.x, G);
        Ptrs P;
        P.x = A->in[0]; P.norm_mix = A->in[1]; P.w_in = A->in[2]; P.q_gain = A->in[3]; P.k_gain = A->in[4]; P.conv_w = A->in[5]; P.conv_b = A->in[6]; P.dt_bias = A->in[7];
        P.a_log = A->in[8]; P.d_skip = A->in[9]; P.attn_gain = A->in[10]; P.ssm_gain = A->in[11]; P.w_out = A->in[12]; P.norm_ffn = A->in[13]; P.w_gate = A->in[14]; P.w_up = A->in[15]; P.w_down = A->in[16];
        P.out = A->out; P.ws = A->ws;
        REPS(0) { prologue(P, lds, vcu, G, wave, lane); grid_bar(lds); } }
    team_setup(lds);

    for (int l = kargs()->l_lo; l < kargs()->l_hi; ++l) {
#define WSP(off) (kargs()->ws + (off))
#define BUF_X ((bf16*)kargs()->out)
#define BUF_V ((bf16*)WSP(WS_XB1))
#define BUF_Z ((bf16*)WSP(WS_XB0))
#define CS_BUF ((bf16*)((unsigned char*)kargs()->out + 128 * MiB))
#define SSQ(k) ((float*)WSP(WS_SSQ + (k)))
        REPS(1) if (IN(1)) {
            { const int tid = tid_of(wv), lane = tid & 63, wave = __builtin_amdgcn_readfirstlane(tid >> 6); const int G = gridDim.x;
              dt_pass(BUF_X, (const bf16*)WSP(WS_WDT) + (size_t)l * 16 * DM, SSQ(SSQ_X0), (float*)WSP(WS_DT), vcu_of(blockIdx.x, G), G, wave, lane, lds); __syncthreads(); }
            pg8::Gemm g{BUF_X, (const bf16*)WSP(WS_WIN) + (size_t)l * NPROJ * DM, M, NPROJ, DM, DM, DM}; pg8::StaticOrder S; S.init(M, NPROJ, (int)gridDim.x, (int)blockIdx.x);
            int gid0;
            { const int tid = tid_of(wv); gid0 = build_rstd_tbl(SSQ(SSQ_X0), (LAS float*)(lds + TBL_OFF), NPROJ, tid);
              if (tid < 256) ((LAS float*)(lds + GAIN_OFF))[tid] = (tid < 128) ? kargs()->in[3][l * HD + tid] * pg8::QSCALE : kargs()->in[4][l * HD + tid - 128];
              __syncthreads(); }
            pg8::EpiProj E{(bf16*)WSP(WS_PROJ), NPROJ, SSQ(SSQ_X0), 1.0f / DM, (const LAS float*)(lds + GAIN_OFF), (LAS float*)(lds + XCH_OFF), (const LAS float*)(lds + TBL_OFF), gid0, PROJ_TOFF};
            pg8::gemm_phase<pg8::EpiProj, pg8::StaticOrder, true, true>(lds, g, S, E, wv);
            team_bar(lds);
        }
        REPS(2) { if (IN(2)) {
            const int tid = tid_of(wv); const int G = gridDim.x;
            ssd::conv_prepass((const bf16*)WSP(WS_PROJ), CS_BUF, kargs()->in[5] + (size_t)l * 4 * CONV_DIM, kargs()->in[6] + (size_t)l * CONV_DIM, vcu_of(blockIdx.x, G), G, tid, lds);
            { att::bf16x8_t qf[8]; v4u kr0, kr1, vr0, vr1; const bf16* proj = (const bf16*)WSP(WS_PROJ);
#define ATT_DECODE(i_, b_, h_, qb_) const int lo_##b_ = (i_) & 255, b_ = ((lo_##b_ >> 5) << 1) | ((lo_##b_ >> 3) & 1), h_ = lo_##b_ & 7, qb_ = 7 - 2 * ((i_) >> 8) - ((lo_##b_ >> 4) & 1)
              const int vcu = vcu_of(blockIdx.x, G);
              { const int i0 = vcu < BATCH * NH * 8 ? vcu : 0; ATT_DECODE(i0, b0, h0, qb0); ATT_LOAD_HEAD(b0, h0, qb0); }
              for (int i = vcu; i < BATCH * NH * 8; i += G) { ATT_DECODE(i, b, h, qb);
                  const int i2 = (i + G < BATCH * NH * 8) ? i + G : i; ATT_DECODE(i2, b2, h2, qb2);
                  att::attn_unit(proj, BUF_V, SSQ(SSQ_ATT), b, h, qb, lds, tid, qf, kr0, kr1, vr0, vr1, b2, h2, qb2); } }
#undef ATT_DECODE
            team_bar(lds);
        }
        if (IN(3)) {
            CArgs* A = kargs(); const int tid = tid_of(wv); const int G = gridDim.x;
            for (int i = vcu_of(blockIdx.x, G); i < BATCH * SNH; i += G) { const int b = i >> 4, head = i & 15;
                ssd::ssd_unit((const bf16*)WSP(WS_PROJ) + (size_t)(b >> 1) * PROJ_TOFF, CS_BUF, (const float*)WSP(WS_DT), BUF_V, SSQ(SSQ_SSM),
                            A->in[7][l * SNH + head], -__expf(A->in[8][l * SNH + head]), A->in[9][l * SNH + head], b, head, lds, tid); }
            team_bar(lds);
        } }
        if (IN(5)) {
            pg8::Gemm g{BUF_V, (const bf16*)WSP(WS_WOUT) + (size_t)l * DM * DM, M, DM, DM, DM, DM}; pg8::KSegOrder S; S.init(M, DM, (int)gridDim.x, (int)blockIdx.x, RESID_WGM);
            { const int tid = tid_of(wv); build_mix_tbl(SSQ(SSQ_ATT), SSQ(SSQ_SSM), (LAS float*)(lds + FTAB_OFF), tid); __syncthreads(); }
            pg8::EpiResid<true> E{BUF_X, BUF_Z, kargs()->out, SSQ(SSQ_X1), DM, 0, (const LAS float*)(lds + FTAB_OFF)};
            pg8::gemm_phase<pg8::EpiResid<true>, pg8::KSegOrder, true, true>(lds, g, S, E, wv);
            team_bar(lds);
        }
        REPS(6) if (IN(6)) {
            pg8::Gemm g{BUF_Z, (const bf16*)WSP(WS_WGU) + (size_t)l * 2 * DFF * DM, M, 2 * DFF, DM, DM, DM}; pg8::StaticOrder S; S.init(M, 2 * DFF, (int)gridDim.x, (int)blockIdx.x);
            int gid0;
            { const int tid = tid_of(wv); gid0 = build_rstd_tbl(SSQ(SSQ_X1), (LAS float*)(lds + TBL_OFF), 2 * DFF, tid); __syncthreads(); }
            pg8::EpiSwiGLU E{(bf16*)WSP(WS_PROJ), DFF_LD, SSQ(SSQ_X1), 1.0f / DM, (const LAS float*)(lds + TBL_OFF), gid0};
            pg8::gemm_phase<pg8::EpiSwiGLU, pg8::StaticOrder, true, true>(lds, g, S, E, wv);
            if (l + 1 == DEPTH) grid_bar(lds); else team_bar(lds);
        }
        if (IN(7)) {
            pg8::Gemm g{(const bf16*)WSP(WS_PROJ), (const bf16*)WSP(WS_WDN) + (size_t)l * DM * DFF_LD, M, DM, DFF, DFF_LD, DFF_LD}; pg8::StaticOrder S; S.init(M, DM, (int)gridDim.x, (int)blockIdx.x, RESID_WGM);
            pg8::EpiResid<false> E{BUF_Z, BUF_X, kargs()->out, SSQ(SSQ_X0), DM, (l + 1 == DEPTH) ? 1 : 0, (const LAS float*)nullptr};
            pg8::gemm_phase<pg8::EpiResid<false>, pg8::StaticOrder, true, true>(lds, g, S, E, wv);
            if (l + 1 < kargs()->l_hi) team_bar(lds);
        }
    }
#undef IN
}

extern "C" void kernel_launch(void* const* d_in, const int* in_sizes, int n_in, void* d_out, int out_size, void* d_ws, size_t ws_size, hipStream_t stream) {
    static int grid = 0;
    if (grid == 0) {
        if (n_in != 17 || in_sizes[0] != M * DM || out_size != M * DM || ws_size < WS_END) { fprintf(stderr, "kernel_launch: shape/workspace mismatch (n_in %d, in0 %d, out %d, ws %zu < %zu); nothing launched\n", n_in, n_in > 0 ? in_sizes[0] : -1, out_size, ws_size, (size_t)WS_END); grid = -1; return; }
        int dev = 0, cus = 0, per_cu = 0;
        if (hipGetDevice(&dev) != hipSuccess || hipDeviceGetAttribute(&cus, hipDeviceAttributeMultiprocessorCount, dev) != hipSuccess) { grid = -1; return; }
        if (hipFuncSetAttribute((const void*)mk_fwd, hipFuncAttributeMaxDynamicSharedMemorySize, LDS_BYTES) != hipSuccess) { fprintf(stderr, "kernel_launch: hipFuncSetAttribute failed\n"); grid = -1; return; }
        if (hipOccupancyMaxActiveBlocksPerMultiprocessor(&per_cu, (const void*)mk_fwd, NT, LDS_BYTES) != hipSuccess || per_cu < 1) fprintf(stderr, "kernel_launch: note: occupancy query reports %d\n", per_cu);
        (void)hipGetLastError();
        grid = cus;
    }
    if (grid < 0) return;
    if (hipMemsetAsync((char*)d_ws, 0, ZERO_BYTES, stream) != hipSuccess) { fprintf(stderr, "kernel_launch: memset failed\n"); return; }
    Args a{};
    for (int i = 0; i < 17; ++i) a.in[i] = (const float*)d_in[i];
    a.out = (float*)d_out; a.ws = (unsigned char*)d_ws;
#if MK_ONE_LAUNCH
    a.l_lo = 0; a.l_hi = DEPTH; a.ph_lo = 1; a.ph_hi = N_PHASES + 1; a.do_pro = 1; a.use_bar = 1;
    hipLaunchKernelGGL(mk_fwd, dim3(grid), dim3(NT), LDS_BYTES, stream, a);
#else
    a.use_bar = 0;
    a.do_pro = 1; a.l_lo = 0; a.l_hi = 0; a.ph_lo = 0; a.ph_hi = 0;
    hipLaunchKernelGGL(mk_fwd, dim3(grid), dim3(NT), LDS_BYTES, stream, a);
    a.do_pro = 0;
    for (int l = 0; l < DEPTH; ++l)
        for (int ph = 1; ph <= N_PHASES; ++ph) { a.l_lo = l; a.l_hi = l + 1; a.ph_lo = ph; a.ph_hi = ph + 1;
            hipLaunchKernelGGL(mk_fwd, dim3(grid), dim3(NT), LDS_BYTES, stream, a); }
#endif
    const hipError_t le = hipPeekAtLastError();
    if (le != hipSuccess) fprintf(stderr, "kernel_launch: launch failed: %s\n", hipGetErrorName(le));
}
```

```cpp
#include <hip/hip_runtime.h>
#include <cstdio>
#include <cstdint>
namespace pg8 {
#define PG8_LAS __attribute__((address_space(3)))
typedef unsigned short bf16_t;
typedef short bf16x8 __attribute__((ext_vector_type(8)));
typedef float f32x4 __attribute__((ext_vector_type(4)));
typedef unsigned u32x4 __attribute__((ext_vector_type(4)));
constexpr int BM = 256, BK = 64, HALF = 128, HTB = HALF * BK * 2  , STAGE_BYTES = 8 * HTB, NXCD = 8, WGM = 8;

__host__ __device__ __forceinline__ int lds_byte(int r, int c) { const int st = (r >> 4) * 2 + (c >> 5), rr = r & 15, cc = c & 31, ob = rr * 64 + cc * 2; return st * 1024 + (ob ^ (((ob >> 9) & 1) << 5)); }
__host__ __device__ __forceinline__ void stage_rc(int b, int& R, int& C) { const int st = b / 1024, sb = b % 1024, swz = sb ^ (((sb >> 9) & 1) << 5); R = (st >> 1) * 16 + swz / 64; C = (st & 1) * 32 + (swz % 64) / 2; }
__host__ __device__ __forceinline__ int perm32(int rho) { const int n = rho >> 4, i = rho & 15; return 8 * (i >> 2) + 4 * n + (i & 3); }

struct Unit { int pm, pn, seg; };
struct Gemm { const bf16_t* A; const bf16_t* Bt; int M, N, K, lda, ldb; };

struct StaticOrder {
    int nM, nN, nwg, G, c, wgm;
    __host__ __device__ void init(int M, int N, int G_, int c_, int wgm_ = WGM) { nM = M / BM; nN = N / BM; nwg = nM * nN; G = G_; c = c_; wgm = wgm_; }
    __host__ __device__ bool next(int i, Unit& u) const {
        const long L = (long)i * G + c; if (L >= nwg) return false;
        int wgid = (int)L; { const int q = nwg / NXCD, r = nwg % NXCD, xcd = wgid % NXCD, off = wgid / NXCD; wgid = (xcd < r ? xcd * (q + 1) : r * (q + 1) + (xcd - r) * q) + off; }
        const int nig = wgm * nN, gid = wgid / nig, fm = gid * wgm, gsz = (nM - fm) < wgm ? (nM - fm) : wgm;
        u.pm = fm + ((wgid % nig) % gsz); u.pn = (wgid % nig) / gsz; u.seg = 0; return true;
    }
    static constexpr bool KSEG = false;
    __host__ __device__ int kt0(const Unit&) const { return 0; }
    __host__ __device__ int nkt(const Unit&, int ntK) const { return ntK; }
    __host__ __device__ bool fresh(const Unit&) const { return true; }
    __device__ __forceinline__ void a_ready(const Unit&) const {}
    __device__ __forceinline__ void done(const Unit&) const {}
};
struct KSegOrder : StaticOrder {
    static constexpr bool KSEG = true;
    __host__ __device__ bool next(int i, Unit& u) const { if (!StaticOrder::next(i / 3, u)) return false; u.seg = i % 3; return true; }
    __host__ __device__ int kt0(const Unit& u) const { return u.seg == 0 ? 0 : (u.seg == 1 ? 16 : 24); }
    __host__ __device__ int nkt(const Unit& u, int) const { return u.seg == 0 ? 16 : 8; }
    __host__ __device__ bool fresh(const Unit& u) const { return u.seg == 0; }
};

__device__ __forceinline__ unsigned cvt_pk_bf16(float lo, float hi) { unsigned r; asm volatile("v_cvt_pk_bf16_f32 %0, %1, %2" : "=v"(r) : "v"(lo), "v"(hi)); return r; }
constexpr float RMS_EPS = 1e-6f;
__device__ __forceinline__ float xsum32(float s) { return s + __shfl_xor(s, 32); }
__device__ __forceinline__ float xsum16(float s) { return s + __shfl_xor(s, 16); }
__device__ __forceinline__ float row_sumsq32(const float* ssq, int row) { const f32x4* p = (const f32x4*)(ssq + (size_t)row * 32); float s = 0.f;
#pragma unroll
    for (int i = 0; i < 8; ++i) { const f32x4 v = p[i]; s += (v[0] + v[1]) + (v[2] + v[3]); }
    return s; }
__device__ __forceinline__ float row_rstd(const float* ssq, int row, float inv_n) { return 1.0f / sqrtf(row_sumsq32(ssq, row) * inv_n + RMS_EPS); }
__device__ __forceinline__ float silu_f(float v) { return v * __builtin_amdgcn_rcpf(1.0f + __expf(-v)); }

constexpr float QSCALE = 0.08838834764831845f * 1.4426950408889634f;
struct EpiProj {
    static constexpr bool PERM = true, AFTER_DRAIN = false, RESCALE = false;
    bf16_t* O; int ldc; const float* ssq; float inv_n; const PG8_LAS float* gains; PG8_LAS float* xch; const PG8_LAS float* tbl; int gid0;
    __device__ __forceinline__ float rstd_of(const Unit& u, int rloc, int row) const { return tbl[(((u.pm >> 3) - gid0) & 3) * 256 + rloc]; }
    __device__ __forceinline__ void operator()(const f32x4 (&acc)[2][2][4][2], const Unit& u, int wr, int wc, int fr, int fq) const {
        asm volatile("" : "+v"(fr), "+v"(fq));
        const int row0 = u.pm * BM + wr * 64 + fr, col0 = u.pn * BM + wc * 32 + 8 * fq;
        if (u.pn < 8) {
#pragma unroll
            for (int ai = 0; ai < 2; ++ai)
#pragma unroll
                for (int m = 0; m < 4; ++m) { const int rloc = ai * HALF + wr * 64 + m * 16 + fr;
#pragma unroll
                    for (int bj = 0; bj < 2; ++bj) { const f32x4 a = acc[ai][bj][m][0], b = acc[ai][bj][m][1];
                        float ss = ((a[0] * a[0] + a[1] * a[1]) + (a[2] * a[2] + a[3] * a[3])) + ((b[0] * b[0] + b[1] * b[1]) + (b[2] * b[2] + b[3] * b[3]));
                        ss = xsum32(xsum16(ss));
                        if (fq == 0) xch[(rloc * 2 + bj) * 4 + wc] = ss; } }
            asm volatile("s_waitcnt lgkmcnt(0)" ::: "memory"); __builtin_amdgcn_s_barrier(); asm volatile("" ::: "memory");
            const PG8_LAS float* gp = gains + ((u.pn < 4) ? 0 : 128) + wc * 32 + 8 * fq;
            const f32x4 g0 = *(const PG8_LAS f32x4*)gp, g1 = *(const PG8_LAS f32x4*)(gp + 4);
#pragma unroll
            for (int ai = 0; ai < 2; ++ai)
#pragma unroll
                for (int m = 0; m < 4; ++m) { const int rloc = ai * HALF + wr * 64 + m * 16 + fr, row = row0 + ai * HALF + m * 16; const float rs = rstd_of(u, rloc, row);
                    bf16_t* rowp = O + (size_t)row * ldc + col0;
#pragma unroll
                    for (int bj = 0; bj < 2; ++bj) { const f32x4 p = *(const PG8_LAS f32x4*)(xch + (rloc * 2 + bj) * 4); const float tot = (p[0] + p[1]) + (p[2] + p[3]);
                        const float hr = rs * __builtin_amdgcn_rsqf(tot * (rs * rs) * (1.0f / 128.0f) + RMS_EPS);
                        const f32x4 v0 = acc[ai][bj][m][0] * hr * g0, v1 = acc[ai][bj][m][1] * hr * g1;
                        u32x4 w; w.x = cvt_pk_bf16(v0[0], v0[1]); w.y = cvt_pk_bf16(v0[2], v0[3]); w.z = cvt_pk_bf16(v1[0], v1[1]); w.w = cvt_pk_bf16(v1[2], v1[3]);
                        *(u32x4*)(rowp + bj * HALF) = w; } }
        } else if (u.pn >= 12 && u.pn < 16) {
#pragma unroll
        for (int ai = 0; ai < 2; ++ai)
#pragma unroll
            for (int m = 0; m < 4; ++m) { const int row = row0 + ai * HALF + m * 16; const float rs = rstd_of(u, ai * HALF + wr * 64 + m * 16 + fr, row);
                bf16_t* rowp = O + (size_t)row * ldc + col0;
#pragma unroll
                for (int bj = 0; bj < 2; ++bj) { const float rsl = rs * -1.4426950408889634f; f32x4 e0 = acc[ai][bj][m][0] * rsl, e1 = acc[ai][bj][m][1] * rsl;
                    __builtin_amdgcn_sched_barrier(0);
#pragma unroll
                    for (int j = 0; j < 4; ++j) { e0[j] = __builtin_amdgcn_exp2f(e0[j]); e1[j] = __builtin_amdgcn_exp2f(e1[j]); }
                    __builtin_amdgcn_sched_barrier(0);
                    e0 = e0 + 1.0f; e1 = e1 + 1.0f;
                    f32x4 v0 = acc[ai][bj][m][0] * rs, v1 = acc[ai][bj][m][1] * rs;
                    __builtin_amdgcn_sched_barrier(0);
#pragma unroll
                    for (int j = 0; j < 4; ++j) { e0[j] = __builtin_amdgcn_rcpf(e0[j]); e1[j] = __builtin_amdgcn_rcpf(e1[j]); }
                    __builtin_amdgcn_sched_barrier(0);
                    v0 = v0 * e0; v1 = v1 * e1;
                    u32x4 w; w.x = cvt_pk_bf16(v0[0], v0[1]); w.y = cvt_pk_bf16(v0[2], v0[3]); w.z = cvt_pk_bf16(v1[0], v1[1]); w.w = cvt_pk_bf16(v1[2], v1[3]);
                    *(u32x4*)(rowp + bj * HALF) = w; } }
        } else {
#pragma unroll
        for (int ai = 0; ai < 2; ++ai)
#pragma unroll
            for (int m = 0; m < 4; ++m) { const int row = row0 + ai * HALF + m * 16; const float rs = rstd_of(u, ai * HALF + wr * 64 + m * 16 + fr, row);
                bf16_t* rowp = O + (size_t)row * ldc + col0;
#pragma unroll
                for (int bj = 0; bj < 2; ++bj) { const f32x4 v0 = acc[ai][bj][m][0] * rs, v1 = acc[ai][bj][m][1] * rs;
                    u32x4 w; w.x = cvt_pk_bf16(v0[0], v0[1]); w.y = cvt_pk_bf16(v0[2], v0[3]); w.z = cvt_pk_bf16(v1[0], v1[1]); w.w = cvt_pk_bf16(v1[2], v1[3]);
                    *(u32x4*)(rowp + bj * HALF) = w; } }
        }
    }
};
struct EpiSwiGLU {
    static constexpr bool PERM = true, AFTER_DRAIN = false, RESCALE = false;
    bf16_t* O; int ldc; const float* ssq; float inv_n; const PG8_LAS float* tbl; int gid0;
    __device__ __forceinline__ void operator()(const f32x4 (&acc)[2][2][4][2], const Unit& u, int wr, int wc, int fr, int fq) const {
        asm volatile("" : "+v"(fr), "+v"(fq));
        const int row0 = u.pm * BM + wr * 64 + fr, col0 = u.pn * HALF + wc * 32 + 8 * fq;
#pragma unroll
        for (int ai = 0; ai < 2; ++ai)
#pragma unroll
            for (int m = 0; m < 4; ++m) { const int row = row0 + ai * HALF + m * 16; const float rs = tbl[(((u.pm >> 3) - gid0) & 3) * 256 + ai * HALF + wr * 64 + m * 16 + fr];
                const float rsl = rs * -1.4426950408889634f, rs2 = rs * rs;
                const f32x4 g0 = acc[ai][0][m][0], g1 = acc[ai][0][m][1], u0 = acc[ai][1][m][0], u1 = acc[ai][1][m][1];
                f32x4 e0 = g0 * rsl, e1 = g1 * rsl;
                __builtin_amdgcn_sched_barrier(0);
#pragma unroll
                for (int j = 0; j < 4; ++j) { e0[j] = __builtin_amdgcn_exp2f(e0[j]); e1[j] = __builtin_amdgcn_exp2f(e1[j]); }
                __builtin_amdgcn_sched_barrier(0);
                e0 = e0 + 1.0f; e1 = e1 + 1.0f;
                const f32x4 p0 = (g0 * u0) * rs2, p1 = (g1 * u1) * rs2;
                __builtin_amdgcn_sched_barrier(0);
#pragma unroll
                for (int j = 0; j < 4; ++j) { e0[j] = __builtin_amdgcn_rcpf(e0[j]); e1[j] = __builtin_amdgcn_rcpf(e1[j]); }
                __builtin_amdgcn_sched_barrier(0);
                const f32x4 h0 = p0 * e0, h1 = p1 * e1;
                u32x4 w; w.x = cvt_pk_bf16(h0[0], h0[1]); w.y = cvt_pk_bf16(h0[2], h0[3]); w.z = cvt_pk_bf16(h1[0], h1[1]); w.w = cvt_pk_bf16(h1[2], h1[3]);
                *(u32x4*)(O + (size_t)row * ldc + col0) = w; }
    }
};
template <bool RS> struct EpiResid {
    static constexpr bool PERM = true, AFTER_DRAIN = false, RESCALE = false;
    const bf16_t* xbi; bf16_t* xb; float* outf; float* ssq_out; int ldc; int final_f32; const PG8_LAS float* ftab;
    __device__ __forceinline__ void mid(f32x4 (&acc)[2][2][4][2], const Unit& u, int wr, int fr) const {
        asm volatile("" : "+v"(fr));
        const PG8_LAS float* f = ftab + ((u.pm >> 2) & 3) * 768 + u.seg * 256 + wr * 64 + fr;
#pragma unroll
        for (int ai = 0; ai < 2; ++ai)
#pragma unroll
            for (int m = 0; m < 4; ++m) { const float sc = f[ai * HALF + m * 16];
#pragma unroll
                for (int bj = 0; bj < 2; ++bj)
#pragma unroll
                    for (int n = 0; n < 2; ++n) acc[ai][bj][m][n] = acc[ai][bj][m][n] * sc; }
    }
    __device__ __forceinline__ void operator()(const f32x4 (&acc)[2][2][4][2], const Unit& u, int wr, int wc, int fr, int fq) const {
        asm volatile("" : "+v"(fr), "+v"(fq));
        const int row0 = u.pm * BM + wr * 64 + fr, col0 = u.pn * BM + wc * 32 + 8 * fq;
#pragma unroll
        for (int ai = 0; ai < 2; ++ai) {
            u32x4 xv[4][2];
#pragma unroll
            for (int m = 0; m < 4; ++m)
#pragma unroll
                for (int bj = 0; bj < 2; ++bj) xv[m][bj] = *(const u32x4*)(xbi + (size_t)(row0 + ai * HALF + m * 16) * ldc + col0 + bj * HALF);
#pragma unroll
            for (int m = 0; m < 4; ++m) { const int row = row0 + ai * HALF + m * 16; float s = 0.f;
                const float s3 = RS ? ftab[((u.pm >> 2) & 3) * 768 + 512 + ai * HALF + wr * 64 + m * 16 + fr] : 1.0f;
#pragma unroll
                for (int bj = 0; bj < 2; ++bj) { const size_t off = (size_t)row * ldc + col0 + bj * HALF; const u32x4 xw = xv[m][bj];
                    f32x4 a0, a1;
                    a0[0] = __builtin_bit_cast(float, xw.x << 16); a0[1] = __builtin_bit_cast(float, xw.x & 0xffff0000u); a0[2] = __builtin_bit_cast(float, xw.y << 16); a0[3] = __builtin_bit_cast(float, xw.y & 0xffff0000u);
                    a1[0] = __builtin_bit_cast(float, xw.z << 16); a1[1] = __builtin_bit_cast(float, xw.z & 0xffff0000u); a1[2] = __builtin_bit_cast(float, xw.w << 16); a1[3] = __builtin_bit_cast(float, xw.w & 0xffff0000u);
                    a0 = a0 + acc[ai][bj][m][0] * s3; a1 = a1 + acc[ai][bj][m][1] * s3;
                    s += (a0[0] * a0[0] + a0[1] * a0[1]) + (a0[2] * a0[2] + a0[3] * a0[3]) + (a1[0] * a1[0] + a1[1] * a1[1]) + (a1[2] * a1[2] + a1[3] * a1[3]);
                    if (final_f32) { *(f32x4*)(outf + off) = a0; *(f32x4*)(outf + off + 4) = a1; }
                    else { u32x4 w; w.x = cvt_pk_bf16(a0[0], a0[1]); w.y = cvt_pk_bf16(a0[2], a0[3]); w.z = cvt_pk_bf16(a1[0], a1[1]); w.w = cvt_pk_bf16(a1[2], a1[3]); *(u32x4*)(xb + off) = w; } }
                s = xsum32(xsum16(s));
                if (fq == 0) ssq_out[(size_t)row * 32 + u.pn * 4 + wc] = s; }
        }
    }
};

template <class Epi, class Sched, bool ALIGN_EPI = false, bool SP2 = false>
__device__ __forceinline__ void gemm_phase(PG8_LAS unsigned char* lds, const Gemm g, const Sched& S, const Epi& E, const int wave_id) {
    int tid_ = threadIdx.x; asm volatile("" : "+v"(tid_));
    const int tid = tid_, wid = __builtin_amdgcn_readfirstlane(tid >> 6), lane = tid & 63, wr = wid >> 2, wc = wid & 3, fr = lane & 15, fq = lane >> 4;
    const int K = g.K, ntK = K / BK;
    unsigned voffA[2], voffB[2];
#pragma unroll
    for (int i = 0; i < 2; ++i) { int R, C; stage_rc(tid * 16 + i * 8192, R, C); const int Rb = Epi::PERM ? ((R & ~31) + perm32(R & 31)) : R;
        voffA[i] = (unsigned)(R * g.lda + C) * 2u; voffB[i] = (unsigned)(Rb * g.ldb + C) * 2u; }
    const size_t kstep = (size_t)(BK * 2);
    const size_t hstepA = (size_t)HALF * g.lda * 2, hstepB = (size_t)HALF * g.ldb * 2;
    const size_t tstepA = 2 * hstepA, tstepB = 2 * hstepB;
    const unsigned ldsw = (unsigned)wid * 1024u;
    const int aoff = lds_byte(wr * 64 + fr, fq * 8), boff = lds_byte(wc * 32 + fr, fq * 8);
#define PG8_SA(b, h) (((b) * 2 + (h)) * HTB)
#define PG8_SB(b, h) ((4 + (b) * 2 + (h)) * HTB)
#define PG8_STAGE(bufoff, gbase, voff) do { _Pragma("unroll") for (int _i = 0; _i < 2; ++_i) \
        __builtin_amdgcn_global_load_lds((const unsigned*)((const char*)(gbase) + (voff)[_i]), (PG8_LAS unsigned*)(lds + (bufoff) + ldsw + _i * 8192), 16, 0, 0); } while (0)
#define PG8_LDA(dst, b, h) do { _Pragma("unroll") for (int m = 0; m < 4; ++m) _Pragma("unroll") for (int k = 0; k < 2; ++k) dst[m][k] = *(const PG8_LAS bf16x8*)(lds + PG8_SA(b, h) + aoff + m * 2048 + k * 1024); } while (0)
#define PG8_LDB(dst, b, h) do { _Pragma("unroll") for (int n = 0; n < 2; ++n) _Pragma("unroll") for (int k = 0; k < 2; ++k) dst[n][k] = *(const PG8_LAS bf16x8*)(lds + PG8_SB(b, h) + boff + n * 2048 + k * 1024); } while (0)
#define PG8_MMA(ai, bj, At, Bt) do { __builtin_amdgcn_s_setprio(1); _Pragma("unroll") for (int m = 0; m < 4; ++m) _Pragma("unroll") for (int n = 0; n < 2; ++n) _Pragma("unroll") for (int k = 0; k < 2; ++k) \
        acc[ai][bj][m][n] = __builtin_amdgcn_mfma_f32_16x16x32_bf16(Bt[n][k], At[m][k], acc[ai][bj][m][n], 0, 0, 0); __builtin_amdgcn_s_setprio(0); } while (0)
#define PG8_WAIT_V(n) asm volatile("s_waitcnt vmcnt(" #n ")" ::: "memory")
#define PG8_WAIT_L(n) asm volatile("s_waitcnt lgkmcnt(" #n ")" ::: "memory")
#define PG8_BAR __builtin_amdgcn_s_barrier()
#define PG8_SCHED __builtin_amdgcn_sched_barrier(0)
    Unit cur, nxt; int ui = 0;
    if (!S.next(0, cur)) return;
    f32x4 acc[2][2][4][2];
#pragma unroll
    for (int a = 0; a < 2; ++a)
#pragma unroll
        for (int b = 0; b < 2; ++b)
#pragma unroll
            for (int m = 0; m < 4; ++m)
#pragma unroll
                for (int n = 0; n < 2; ++n) acc[a][b][m][n] = (f32x4){0.f, 0.f, 0.f, 0.f};
    bf16x8 At[4][2], B0[2][2], B1[2][2];
    const char* cA = (const char*)g.A + (size_t)cur.pm * tstepA + (size_t)S.kt0(cur) * kstep; const char* cB = (const char*)g.Bt + (size_t)cur.pn * tstepB + (size_t)S.kt0(cur) * kstep;
    S.a_ready(cur);
    if constexpr (SP2) {
        PG8_STAGE(PG8_SB(0, 0), cB, voffB); PG8_STAGE(PG8_SB(0, 1), cB + hstepB, voffB); PG8_STAGE(PG8_SA(0, 0), cA, voffA); PG8_STAGE(PG8_SA(0, 1), cA + hstepA, voffA);
        if (wr == 1) PG8_BAR;
        PG8_WAIT_V(2); PG8_BAR;
        PG8_STAGE(PG8_SB(1, 0), cB + kstep, voffB); PG8_STAGE(PG8_SA(1, 0), cA + kstep, voffA); PG8_STAGE(PG8_SB(1, 1), cB + hstepB + kstep, voffB);
        PG8_WAIT_V(6); PG8_BAR;
    } else {
        PG8_STAGE(PG8_SB(0, 0), cB, voffB); PG8_STAGE(PG8_SA(0, 0), cA, voffA); PG8_STAGE(PG8_SB(0, 1), cB + hstepB, voffB); PG8_STAGE(PG8_SA(0, 1), cA + hstepA, voffA);
        if (wr == 1) PG8_BAR;
        PG8_WAIT_V(4); PG8_BAR;
        PG8_STAGE(PG8_SB(1, 0), cB + kstep, voffB); PG8_STAGE(PG8_SA(1, 0), cA + kstep, voffA); PG8_STAGE(PG8_SB(1, 1), cB + hstepB + kstep, voffB);
        PG8_WAIT_V(6); PG8_BAR;
    }
    for (;;) {
        const bool has_next = S.next(ui + 1, nxt);
        const char* nA = has_next ? (const char*)g.A + (size_t)nxt.pm * tstepA + (size_t)S.kt0(nxt) * kstep : cA; const char* nB = has_next ? (const char*)g.Bt + (size_t)nxt.pn * tstepB + (size_t)S.kt0(nxt) * kstep : cB;
        const int nt = S.nkt(cur, ntK);
        for (int t = 0; t < nt; t += 2) {
            const bool last = (t == nt - 2);
            const char* a1 = cA + (size_t)(t + 1) * kstep;
            const char* a2 = last ? nA : cA + (size_t)(t + 2) * kstep; const char* b2 = last ? nB : cB + (size_t)(t + 2) * kstep;
            const char* a3 = a2 + kstep; const char* b3 = b2 + kstep;
            if (last && has_next) S.a_ready(nxt);
            if constexpr (SP2) {
            PG8_LDB(B0, 0, 0); PG8_LDB(B1, 0, 1); PG8_SCHED; PG8_LDA(At, 0, 0); PG8_STAGE(PG8_SA(1, 1), a1 + hstepA, voffA);
            PG8_WAIT_V(8); PG8_WAIT_L(0); PG8_BAR; PG8_MMA(0, 0, At, B0); PG8_MMA(0, 1, At, B1); PG8_BAR; PG8_SCHED;
            PG8_LDA(At, 0, 1); PG8_STAGE(PG8_SB(0, 0), b2, voffB); PG8_STAGE(PG8_SB(0, 1), b2 + hstepB, voffB); PG8_STAGE(PG8_SA(0, 0), a2, voffA);
            PG8_WAIT_V(8); PG8_WAIT_L(0); PG8_BAR; PG8_MMA(1, 0, At, B0); PG8_MMA(1, 1, At, B1); PG8_BAR; PG8_SCHED;
            PG8_LDB(B0, 1, 0); PG8_LDB(B1, 1, 1); PG8_SCHED; PG8_LDA(At, 1, 0); PG8_STAGE(PG8_SA(0, 1), a2 + hstepA, voffA);
            PG8_WAIT_V(8); PG8_WAIT_L(0); PG8_BAR; PG8_MMA(0, 0, At, B0); PG8_MMA(0, 1, At, B1); PG8_BAR; PG8_SCHED;
            PG8_LDA(At, 1, 1); PG8_STAGE(PG8_SB(1, 0), b3, voffB); PG8_STAGE(PG8_SB(1, 1), b3 + hstepB, voffB); PG8_STAGE(PG8_SA(1, 0), a3, voffA);
            PG8_WAIT_V(8); PG8_WAIT_L(0); PG8_BAR; PG8_MMA(1, 0, At, B0); PG8_MMA(1, 1, At, B1); PG8_BAR; PG8_SCHED;
            } else {
            PG8_LDB(B0, 0, 0); PG8_SCHED; PG8_LDA(At, 0, 0); PG8_STAGE(PG8_SA(1, 1), a1 + hstepA, voffA);
            PG8_WAIT_L(8); PG8_BAR; PG8_WAIT_L(0); PG8_MMA(0, 0, At, B0); PG8_BAR; PG8_SCHED;
            PG8_LDB(B1, 0, 1); PG8_STAGE(PG8_SB(0, 0), b2, voffB);
            PG8_BAR; PG8_WAIT_L(0); PG8_MMA(0, 1, At, B1); PG8_BAR;
            PG8_LDA(At, 0, 1); PG8_STAGE(PG8_SA(0, 0), a2, voffA);
            PG8_BAR; PG8_WAIT_L(0); PG8_MMA(1, 0, At, B0); PG8_BAR; PG8_SCHED;
            PG8_STAGE(PG8_SB(0, 1), b2 + hstepB, voffB);
            PG8_WAIT_V(6); PG8_BAR; PG8_MMA(1, 1, At, B1); PG8_BAR;
            PG8_LDB(B0, 1, 0); PG8_SCHED; PG8_LDA(At, 1, 0); PG8_STAGE(PG8_SA(0, 1), a2 + hstepA, voffA);
            PG8_WAIT_L(8); PG8_BAR; PG8_WAIT_L(0); PG8_MMA(0, 0, At, B0); PG8_BAR; PG8_SCHED;
            PG8_LDB(B1, 1, 1); PG8_STAGE(PG8_SB(1, 0), b3, voffB);
            PG8_BAR; PG8_WAIT_L(0); PG8_MMA(0, 1, At, B1); PG8_BAR;
            PG8_LDA(At, 1, 1); PG8_STAGE(PG8_SA(1, 0), a3, voffA);
            PG8_BAR; PG8_WAIT_L(0); PG8_MMA(1, 0, At, B0); PG8_BAR; PG8_SCHED;
            PG8_STAGE(PG8_SB(1, 1), b3 + hstepB, voffB);
            PG8_WAIT_V(6); PG8_BAR; PG8_MMA(1, 1, At, B1); PG8_BAR;
            }
        }
        if constexpr (ALIGN_EPI) { if (wr == 0) PG8_BAR; }
        if constexpr (!Epi::AFTER_DRAIN) { if constexpr (Sched::KSEG) { if (cur.seg < 2) E.mid(acc, cur, wr, fr); else E(acc, cur, wr, wc, fr, fq); } else E(acc, cur, wr, wc, fr, fq); S.done(cur); }
        if (!has_next) break;
        if (S.fresh(nxt))
#pragma unroll
        for (int a = 0; a < 2; ++a)
#pragma unroll
            for (int b = 0; b < 2; ++b)
#pragma unroll
                for (int m = 0; m < 4; ++m)
#pragma unroll
                    for (int n = 0; n < 2; ++n) acc[a][b][m][n] = (f32x4){0.f, 0.f, 0.f, 0.f};
        cur = nxt; cA = nA; cB = nB; ++ui;
        if constexpr (ALIGN_EPI) { if (wr == 1) PG8_BAR; }
    }
    PG8_WAIT_V(0);
    if constexpr (!ALIGN_EPI) { if (wr == 0) PG8_BAR; }
    PG8_BAR;
    if constexpr (Epi::AFTER_DRAIN) { E.fused(acc, cur, wr, wc, fr, fq, lds, wid, lane); S.done(cur); }
#undef PG8_SA
#undef PG8_SB
#undef PG8_STAGE
#undef PG8_LDA
#undef PG8_LDB
#undef PG8_MMA
#undef PG8_WAIT_V
#undef PG8_WAIT_L
#undef PG8_BAR
#undef PG8_SCHED
}
}

#ifndef MK_ONE_LAUNCH
#define MK_ONE_LAUNCH 1
#endif
constexpr int NWAVES = 8, NT = NWAVES * 64;

constexpr int BATCH = 16, SEQ = 2048, DM = 2048, DEPTH = 4;
constexpr int M = BATCH * SEQ;
constexpr int HD = 128, NH = 8, SHD = 64, SNH = 16, NST = 128, DFF = 5632;
constexpr int DFF_LD = 5696;
constexpr int IN_DIM = 5648, NPROJ = 5632;
constexpr int COL_K = 1024, COL_V = 2048, COL_Z = 3072, COL_XBC = 4096, CONV_DIM = 1536;
constexpr int N_PHASES = 7;

constexpr size_t MiB = 1u << 20;
constexpr size_t WS_CTL = 0;
constexpr size_t ZERO_BYTES = 1 * MiB;
constexpr size_t WS_DT = 4 * MiB;
constexpr size_t WS_WDT = 6 * MiB;
constexpr size_t WS_WIN = 8 * MiB;
constexpr size_t WS_WOUT = 96 * MiB;
constexpr size_t WS_WGU = 128 * MiB;
constexpr size_t WS_WDN = 304 * MiB;
constexpr size_t WS_XB0 = 394 * MiB;
constexpr size_t WS_XB1 = 522 * MiB;
constexpr size_t WS_PROJ = 650 * MiB;
constexpr size_t WS_SSQ = 1006 * MiB;
constexpr size_t SSQ_X0 = 0, SSQ_X1 = (size_t)M * 32 * 4, SSQ_ATT = (size_t)M * 64 * 4, SSQ_SSM = (size_t)M * 72 * 4;
constexpr size_t WS_END = 1020 * MiB;
static_assert(WS_SSQ + (size_t)M * 104 * 4 <= WS_END && WS_DT + (size_t)M * 16 * 4 <= WS_WDT && WS_WDT + (size_t)DEPTH * 16 * DM * 2 <= WS_WIN, "ws map a");
static_assert(WS_WIN + (size_t)DEPTH * NPROJ * DM * 2 <= WS_WOUT && WS_WOUT + (size_t)DEPTH * DM * DM * 2 <= WS_WGU && WS_WGU + (size_t)DEPTH * 2 * DFF * DM * 2 <= WS_WDN, "ws map b");
static_assert(WS_WDN + (size_t)DEPTH * DM * DFF_LD * 2 <= WS_XB0 && WS_XB0 + (size_t)M * DM * 2 <= WS_XB1 && WS_XB1 + (size_t)M * DM * 2 <= WS_PROJ && WS_PROJ + (size_t)M * DFF_LD * 2 <= WS_SSQ, "ws map c");
constexpr int CW_BAR = 4096;

constexpr int RING_BYTES = 131072;
constexpr int XCH_OFF = RING_BYTES + 1024;
constexpr int FTAB_OFF = RING_BYTES + 1024;
constexpr int TBL_OFF = RING_BYTES + 9216;
constexpr int GAIN_OFF = TBL_OFF + 4096;
constexpr int MISC_OFF = 147456 - 128;
constexpr int LDS_BYTES = 147456;

#define GAS __attribute__((address_space(1)))
#define LAS __attribute__((address_space(3)))
typedef unsigned short bf16;
typedef unsigned v4u __attribute__((ext_vector_type(4)));
typedef unsigned v2u __attribute__((ext_vector_type(2)));
typedef float f32x4 __attribute__((ext_vector_type(4)));
typedef short bf16x8 __attribute__((ext_vector_type(8)));
typedef GAS unsigned gu32;
#define RLX_AGENT __ATOMIC_RELAXED, __HIP_MEMORY_SCOPE_AGENT
#define LDS_WAIT() asm volatile("s_waitcnt lgkmcnt(0)" ::: "memory")
#define VM_WAIT() asm volatile("s_waitcnt vmcnt(0)" ::: "memory")
__device__ __forceinline__ unsigned f2bf(float f) { unsigned u = __builtin_bit_cast(unsigned, f); return (u + 0x7fffu + ((u >> 16) & 1u)) >> 16; }
__device__ __forceinline__ unsigned pk2(float lo, float hi) { return f2bf(lo) | (f2bf(hi) << 16); }
__device__ __forceinline__ float bflo(unsigned w) { return __builtin_bit_cast(float, w << 16); }
__device__ __forceinline__ float bfhi(unsigned w) { return __builtin_bit_cast(float, w & 0xffff0000u); }
__device__ __forceinline__ float bf1(bf16 h) { return __builtin_bit_cast(float, (unsigned)h << 16); }
__device__ __forceinline__ float wave_sum(float v) {
#pragma unroll
    for (int o = 1; o < 64; o <<= 1) v += __shfl_xor(v, o);
    return v;
}
constexpr float EPS = 1e-6f;
#define XB_TMO      128
#define XB_XCNT(j)  (256  + 64 * (j))
#define XB_XSUB(j)  (1280 + 64 * (j))
#define XB_XGEN(j)  (2304 + 64 * (j))
#define XB_TOP      3328
#define XB_TOPGEN   3392
#define XCD_BAR_WORDS 3456
#define XB_SPIN_CAP (1u << 18)

__device__ __forceinline__ unsigned xb_ld(unsigned* p)              { return __hip_atomic_load(p, __ATOMIC_RELAXED, __HIP_MEMORY_SCOPE_AGENT); }
__device__ __forceinline__ unsigned xb_add(unsigned* p, unsigned v) { return __hip_atomic_fetch_add(p, v, __ATOMIC_RELAXED, __HIP_MEMORY_SCOPE_AGENT); }
__device__ __forceinline__ unsigned xb_xcc_id() { return (unsigned)__builtin_amdgcn_s_getreg((3 << 11) | 20) & 0xFu; }
#define XB_SPIN(cond, bar) do { unsigned _sp = 0; while (cond) { __builtin_amdgcn_s_sleep(1); \
    if ((++_sp & 255u) == 0u) { if (xb_ld(&(bar)[XB_TMO])) break; if (_sp > XB_SPIN_CAP) { atomicAdd(&(bar)[XB_TMO], 1u); break; } } } } while (0)

struct XcdBarrier {
    unsigned* bar; unsigned x;
    volatile LAS unsigned* st;
};

__device__ __forceinline__ XcdBarrier xcd_barrier_post(unsigned* bar, volatile LAS unsigned* st) {
    XcdBarrier b; b.bar = bar; b.x = xb_xcc_id(); b.st = st;
    if (threadIdx.x == 0) (void)xb_add(&bar[XB_XCNT(b.x)], 1u);
    return b;
}
__device__ __forceinline__ void xcd_barrier_complete(unsigned* bar, unsigned x, unsigned& nloc, unsigned& nx) {
    const unsigned G = gridDim.x * gridDim.y * gridDim.z;
    unsigned sum, cnt, mine, sp = 0u;
    for (;;) {
        sum = 0u; cnt = 0u; mine = 0u;
#pragma unroll
        for (unsigned j = 0; j < 16; ++j) { const unsigned c = xb_ld(&bar[XB_XCNT(j)]); sum += c; cnt += (c > 0u) ? 1u : 0u; mine = (j == x) ? c : mine; }
        if (sum == G) break;
        __builtin_amdgcn_s_sleep(1);
        if ((++sp & 255u) == 0u) { if (xb_ld(&bar[XB_TMO])) break; if (sp > XB_SPIN_CAP) { atomicAdd(&bar[XB_TMO], 1u); break; } }
    }
    nloc = mine > 0u ? mine : 1u; nx = cnt > 0u ? cnt : 1u;
}

__device__ __forceinline__ void xcd_barrier(const XcdBarrier& b) {
    asm volatile("s_waitcnt vmcnt(0)" ::: "memory");
    __syncthreads();
    if (threadIdx.x == 0) {
        unsigned* bar = b.bar;
        __builtin_amdgcn_s_waitcnt(0);
        unsigned nloc = b.st[0], nx = b.st[1];
        if (nloc == 0u) { xcd_barrier_complete(bar, b.x, nloc, nx); b.st[0] = nloc; b.st[1] = nx; }
        const unsigned old = xb_add(&bar[XB_XSUB(b.x)], 1u);
        const unsigned gen = old / nloc;
        if (old + 1u == (gen + 1u) * nloc) {
            __builtin_amdgcn_fence(__ATOMIC_RELEASE, "agent");
            asm volatile("s_waitcnt vmcnt(0)" ::: "memory");
            const unsigned og = xb_add(&bar[XB_TOP], 1u);
            const unsigned tg = og / nx;
            if (og + 1u == (tg + 1u) * nx) xb_add(&bar[XB_TOPGEN], 1u);
            else XB_SPIN(xb_ld(&bar[XB_TOPGEN]) == tg, bar);
            __builtin_amdgcn_fence(__ATOMIC_ACQUIRE, "agent");
            xb_add(&bar[XB_XGEN(b.x)], 1u);
            asm volatile("s_waitcnt vmcnt(0)" ::: "memory");
        } else {
            XB_SPIN(xb_ld(&bar[XB_XGEN(b.x)]) == gen, bar);
            __builtin_amdgcn_fence(__ATOMIC_ACQUIRE, "agent");
            asm volatile("s_waitcnt vmcnt(0)" ::: "memory");
        }
    }
    __syncthreads();
}

__device__ __forceinline__ void transpose_item(const float* W, int ldw, int k0, int n0, const float* gain, bf16* WT, int ldt, int drow0, LAS float* scr, int lane) {
    float wv_[64];
#pragma unroll
    for (int i = 0; i < 64; ++i) wv_[i] = W[(size_t)(k0 + i) * ldw + n0 + lane];
#pragma unroll
    for (int i = 0; i < 64; ++i) { const float gn = gain ? gain[k0 + i] : 1.0f; scr[i * 65 + lane] = wv_[i] * gn; }
    LDS_WAIT(); asm volatile("" ::: "memory");
    const int c = lane & 7;
#pragma unroll
    for (int j = 0; j < 8; ++j) { const int n = (lane >> 3) + 8 * j; const LAS float* s = scr + (8 * c) * 65 + n;
        v4u o; o.x = pk2(s[0 * 65], s[1 * 65]); o.y = pk2(s[2 * 65], s[3 * 65]); o.z = pk2(s[4 * 65], s[5 * 65]); o.w = pk2(s[6 * 65], s[7 * 65]);
        *(GAS v4u*)(WT + (size_t)(drow0 + n) * ldt + k0 + 8 * c) = o; }
    LDS_WAIT(); asm volatile("" ::: "memory");
}

struct Ptrs {
    const float *x, *norm_mix, *w_in, *q_gain, *k_gain, *conv_w, *conv_b, *dt_bias, *a_log, *d_skip, *attn_gain, *ssm_gain, *w_out, *norm_ffn, *w_gate, *w_up, *w_down;
    float* out; unsigned char* ws;
};

__device__ __forceinline__ void prologue(const Ptrs& P, LAS unsigned char* lds, int vcu, int G, int wave, int lane) {
    LAS float* scr = (LAS float*)(lds + wave * 16640);
    const int gw = vcu * NWAVES + wave, NGW = G * NWAVES;
    bf16* WIN = (bf16*)(P.ws + WS_WIN); bf16* WOUT = (bf16*)(P.ws + WS_WOUT); bf16* WGU = (bf16*)(P.ws + WS_WGU); bf16* WDN = (bf16*)(P.ws + WS_WDN);
    constexpr int I_IN = 32 * 88, I_OUT = 32 * 32, I_G = 32 * 88, I_DN = 88 * 32, I_LAYER = I_IN + I_OUT + 2 * I_G + I_DN;
    for (int it = gw; it < DEPTH * I_LAYER; it += NGW) {
        const int l = it / I_LAYER; int r = it % I_LAYER;
        if (r < I_IN) { const int kb = r / 88, nb = r % 88;
            transpose_item(P.w_in + (size_t)l * DM * IN_DIM, IN_DIM, 64 * kb, 64 * nb, P.norm_mix + l * DM, WIN + (size_t)l * NPROJ * DM, DM, 64 * nb, scr, lane); continue; }
        r -= I_IN;
        if (r < I_OUT) { const int kb = r / 32, nb = r % 32; const int k0 = 64 * kb;
            const float* gain = (k0 < 1024) ? (P.attn_gain + l * 1024) : (P.ssm_gain + l * 1024 - 1024);
            transpose_item(P.w_out + (size_t)l * DM * DM, DM, k0, 64 * nb, gain, WOUT + (size_t)l * DM * DM, DM, 64 * nb, scr, lane); continue; }
        r -= I_OUT;
        if (r < 2 * I_G) { const int up = r / I_G; r -= up * I_G; const int kb = r / 88, nb = r % 88; const int n0 = 64 * nb;
            const float* W = (up ? P.w_up : P.w_gate) + (size_t)l * DM * DFF;
            transpose_item(W, DFF, 64 * kb, n0, P.norm_ffn + l * DM, WGU + (size_t)l * 2 * DFF * DM, DM, 256 * (n0 / 128) + (n0 % 128) + 128 * up, scr, lane); continue; }
        r -= 2 * I_G;
        { const int kb = r / 32, nb = r % 32;
            transpose_item(P.w_down + (size_t)l * DFF * DM, DM, 64 * kb, 64 * nb, nullptr, WDN + (size_t)l * DM * DFF_LD, DFF_LD, 64 * nb, scr, lane); }
    }
    { bf16* WDT = (bf16*)(P.ws + WS_WDT);
      for (int idx = gw * 64 + lane; idx < DEPTH * 16 * DM; idx += NGW * 64) { const int l = idx / (16 * DM), j = (idx / DM) % 16, k = idx % DM;
          WDT[idx] = (bf16)f2bf(P.w_in[(size_t)l * DM * IN_DIM + (size_t)k * IN_DIM + NPROJ + j] * P.norm_mix[l * DM + k]); } }
    { bf16* XB0 = (bf16*)P.out; float* ssq = (float*)(P.ws + WS_SSQ + SSQ_X0);
      for (int row = gw; row < M; row += NGW) {
          const GAS f32x4* xr = (const GAS f32x4*)(P.x + (size_t)row * DM) + lane; GAS v2u* o8 = (GAS v2u*)(XB0 + (size_t)row * DM) + lane;
          float s = 0.f;
#pragma unroll
          for (int j = 0; j < 8; ++j) { const f32x4 v = xr[64 * j]; s += (v.x * v.x + v.y * v.y) + (v.z * v.z + v.w * v.w); v2u w; w.x = pk2(v.x, v.y); w.y = pk2(v.z, v.w); o8[64 * j] = w; }
          s = wave_sum(s);
          if (lane < 32) ssq[(size_t)row * 32 + lane] = (lane == 0) ? s : 0.f; } }
}

__device__ __forceinline__ void dt_pass(const bf16* xb, const bf16* wdt, const float* ssq, float* dtbuf, int vcu, int G, int wave, int lane, LAS unsigned char* lds) {
    constexpr int WPITCH = 2 * DM + 16;
    { const int tid = wave * 64 + lane;
      __syncthreads();
#pragma unroll
      for (int i = 0; i < (16 * DM * 2 / 16) / NT; ++i) { const int n = tid + NT * i, r = n >> 8, c = n & 255;
          *(LAS v4u*)(lds + r * WPITCH + 16 * c) = *(const v4u*)(wdt + (size_t)r * DM + 8 * c); }
      __syncthreads(); }
    const int gw = vcu * NWAVES + wave, NGW = G * NWAVES;
    for (int g = gw; g < M / 16; g += NGW) {
        const int row0 = 16 * g;
        const bf16* ap = xb + (size_t)(row0 + (lane & 15)) * DM + 8 * (lane >> 4);
        const LAS unsigned char* bp = lds + (lane & 15) * WPITCH + 16 * (lane >> 4);
        f32x4 acc = (f32x4){0.f, 0.f, 0.f, 0.f};
#pragma unroll 8
        for (int s = 0; s < DM / 32; ++s) { const bf16x8 a = *(const bf16x8*)(ap + 32 * s), b = *(const LAS bf16x8*)(bp + 64 * s);
            acc = __builtin_amdgcn_mfma_f32_16x16x32_bf16(a, b, acc, 0, 0, 0); }
#pragma unroll
        for (int i = 0; i < 4; ++i) { const int row = row0 + 4 * (lane >> 4) + i; const float rs = pg8::row_rstd(ssq, row, 1.0f / DM);
            dtbuf[(size_t)row * 16 + (lane & 15)] = acc[i] * rs; }
    }
}

namespace att {
typedef bf16x8 bf16x8_t;
typedef float f32x16 __attribute__((ext_vector_type(16)));
typedef short s16x4 __attribute__((ext_vector_type(4)));
constexpr float ATT_STOP = 1e-24f;
constexpr int KBUF0 = 0, VBUF0 = 32768, TILE_BYTES = 16384, FLAGS = 65536;
__device__ __forceinline__ unsigned off_b(unsigned row, unsigned ch) { return 256u * row + 16u * (ch ^ (((row & 3) << 2) | ((row >> 2) & 3))); }
__device__ __forceinline__ unsigned cvtpk(float lo, float hi) { unsigned r; asm volatile("v_cvt_pk_bf16_f32 %0, %1, %2" : "=v"(r) : "v"(lo), "v"(hi)); return r; }

template <bool DIAG> __device__ __forceinline__ void stick_block(const f32x16& sa, float& P, float (&W)[16], int kq, int hh) {
    float rr[16];
#pragma unroll
    for (int r = 0; r < 16; ++r) { const float u = __builtin_amdgcn_exp2f(sa[r]); float r1 = __builtin_amdgcn_rcpf(1.0f + u);
        if (DIAG) { const bool valid = (kq + (r & 3) + 8 * (r >> 2) + 4 * hh) < 0; r1 = valid ? r1 : 1.0f; }
        rr[r] = r1; }
    float Gq[4], Gp[4];
#pragma unroll
    for (int g = 0; g < 4; ++g) { Gq[g] = (rr[4 * g] * rr[4 * g + 1]) * (rr[4 * g + 2] * rr[4 * g + 3]); Gp[g] = __shfl_xor(Gq[g], 32); }
    float T = P;
#pragma unroll
    for (int g = 3; g >= 0; --g) { const float base = T * (hh ? 1.0f : Gp[g]);
        const float e3 = base, e2 = e3 * rr[4 * g + 3], e1 = e2 * rr[4 * g + 2], e0 = e1 * rr[4 * g + 1];
        W[4 * g + 3] = e3 - rr[4 * g + 3] * e3; W[4 * g + 2] = e2 - rr[4 * g + 2] * e2; W[4 * g + 1] = e1 - rr[4 * g + 1] * e1; W[4 * g] = e0 - rr[4 * g] * e0;
        T = T * (Gq[g] * Gp[g]); }
    P = T;
}

#define ATT_LOAD_HEAD(b_, h_, qb_) do { int tz_ = tid; asm volatile("" : "+v"(tz_)); const int ln_ = tz_ & 63, wv_ = __builtin_amdgcn_readfirstlane(tz_ >> 6); \
        const size_t rb_ = (size_t)(b_) * SEQ; const int t0_ = 256 * (qb_); \
        const bf16* qp_ = proj + (rb_ + t0_ + 32 * wv_ + (ln_ & 31)) * NPROJ + (h_) * HD + 8 * (ln_ >> 5); \
        _Pragma("unroll") for (int ks_ = 0; ks_ < 8; ++ks_) qf[ks_] = *(const bf16x8*)(qp_ + 16 * ks_); \
        const bf16* kp_ = proj + (rb_ + (tz_ >> 4) + 64 * (t0_ / 64 + 3)) * NPROJ + COL_K + (h_) * HD + 8 * (tz_ & 15); \
        kr0 = *(const v4u*)kp_; kr1 = *(const v4u*)(kp_ + (size_t)32 * NPROJ); vr0 = *(const v4u*)(kp_ + (COL_V - COL_K)); vr1 = *(const v4u*)(kp_ + (size_t)32 * NPROJ + (COL_V - COL_K)); } while (0)
__device__ __forceinline__ void attn_unit(const bf16* proj, bf16* mix, float* ssq_att, int b, int h, int qb, LAS unsigned char* lds, int tid,
                                          bf16x8 (&qf)[8], v4u& kr0, v4u& kr1, v4u& vr0, v4u& vr1, int nb, int nh, int nqb) {
    const int lane = tid & 63, wave = __builtin_amdgcn_readfirstlane(tid >> 6), qi = lane & 31, hh = lane >> 5;
    const int t0 = 256 * qb, q0 = t0 + 32 * wave;
    const size_t rowbase = (size_t)b * SEQ;
    f32x16 oT[4];
#pragma unroll
    for (int c = 0; c < 4; ++c)
#pragma unroll
        for (int r = 0; r < 16; ++r) oT[c][r] = 0.f;
    float P = 1.0f; bool wdone = false;
    const unsigned kbase = off_b(qi, hh);
    unsigned vbase[2];
    { const unsigned blk = (lane >> 4) & 1, q4 = (lane & 15) >> 2, p = lane & 3;
#pragma unroll
      for (int t = 0; t < 2; ++t) vbase[t] = off_b(8 * t + 4 * hh + q4, 2 * blk + (p >> 1)) + 8 * (p & 1); }
    const int srow = tid >> 4, sch = tid & 15;
    const bf16* kg0 = proj + (rowbase + srow) * NPROJ + COL_K + h * HD + 8 * sch;
    const unsigned soff0 = off_b(srow, sch), soff1 = off_b(srow + 32, sch);
    const int nt = t0 / 64 + 4;
    __syncthreads();
    *(LAS v4u*)(lds + KBUF0 + soff0) = kr0; *(LAS v4u*)(lds + KBUF0 + soff1) = kr1; *(LAS v4u*)(lds + VBUF0 + soff0) = vr0; *(LAS v4u*)(lds + VBUF0 + soff1) = vr1;
    __syncthreads();
    for (int it = 0; it < nt; ++it) {
        const int kt = nt - 1 - it, s0 = 64 * kt, buf = it & 1;
        if (it + 1 < nt) { const bf16* kp = kg0 + (size_t)(s0 - 64) * NPROJ;
            kr0 = *(const v4u*)kp; kr1 = *(const v4u*)(kp + (size_t)32 * NPROJ); vr0 = *(const v4u*)(kp + (COL_V - COL_K)); vr1 = *(const v4u*)(kp + (size_t)32 * NPROJ + (COL_V - COL_K)); }
        const LAS unsigned char* kimg = lds + KBUF0 + buf * TILE_BYTES; const LAS unsigned char* vimg = lds + VBUF0 + buf * TILE_BYTES;
#pragma unroll
        for (int blk = 1; blk >= 0; --blk) {
            const int kb0 = s0 + 32 * blk;
            if (kb0 <= q0 + 30 && !wdone) {
                f32x16 sa;
#pragma unroll
                for (int r = 0; r < 16; ++r) sa[r] = 0.f;
#pragma unroll
                for (int ks = 0; ks < 8; ++ks) { const bf16x8 kf = *(const LAS bf16x8*)(kimg + ((kbase ^ (unsigned)(ks << 5)) + 8192u * blk));
                    sa = __builtin_amdgcn_mfma_f32_32x32x16_bf16(kf, qf[ks], sa, 0, 0, 0); }
                s16x4 vlo[4], vhi[4], wlo[4], whi[4];
#pragma unroll
                for (int c = 0; c < 4; ++c) {
                    vlo[c] = __builtin_amdgcn_ds_read_tr16_b64_v4i16((LAS s16x4*)(vimg + ((vbase[0] ^ (unsigned)(c << 6)) + 8192u * blk)));
                    vhi[c] = __builtin_amdgcn_ds_read_tr16_b64_v4i16((LAS s16x4*)(vimg + ((vbase[1] ^ (unsigned)(c << 6)) + 8192u * blk))); }
                __builtin_amdgcn_sched_barrier(0);
                float W[16];
                if (kb0 + 31 >= q0) stick_block<true>(sa, P, W, kb0 - (q0 + qi), hh);
                else stick_block<false>(sa, P, W, 0, hh);
#pragma unroll
                for (int c = 0; c < 4; ++c) {
                    wlo[c] = __builtin_amdgcn_ds_read_tr16_b64_v4i16((LAS s16x4*)(vimg + ((vbase[0] ^ (unsigned)(c << 6)) + 4096u + 8192u * blk)));
                    whi[c] = __builtin_amdgcn_ds_read_tr16_b64_v4i16((LAS s16x4*)(vimg + ((vbase[1] ^ (unsigned)(c << 6)) + 4096u + 8192u * blk))); }
                __builtin_amdgcn_sched_barrier(0);
                { v4u wp; wp.x = cvtpk(W[0], W[1]); wp.y = cvtpk(W[2], W[3]); wp.z = cvtpk(W[4], W[5]); wp.w = cvtpk(W[6], W[7]);
                  const bf16x8 wf = __builtin_bit_cast(bf16x8, wp);
#pragma unroll
                  for (int c = 0; c < 4; ++c) oT[c] = __builtin_amdgcn_mfma_f32_32x32x16_bf16(__builtin_shufflevector(vlo[c], vhi[c], 0, 1, 2, 3, 4, 5, 6, 7), wf, oT[c], 0, 0, 0); }
                { v4u wp; wp.x = cvtpk(W[8], W[9]); wp.y = cvtpk(W[10], W[11]); wp.z = cvtpk(W[12], W[13]); wp.w = cvtpk(W[14], W[15]);
                  const bf16x8 wf = __builtin_bit_cast(bf16x8, wp);
#pragma unroll
                  for (int c = 0; c < 4; ++c) oT[c] = __builtin_amdgcn_mfma_f32_32x32x16_bf16(__builtin_shufflevector(wlo[c], whi[c], 0, 1, 2, 3, 4, 5, 6, 7), wf, oT[c], 0, 0, 0); }
            }
        }
        { wdone = __all(P < ATT_STOP); if (lane == 0) ((LAS unsigned*)(lds + FLAGS))[(it & 1) * 8 + wave] = wdone ? 1u : 0u; }
        if (it + 1 < nt) { const unsigned nb = (buf ^ 1) * TILE_BYTES;
            *(LAS v4u*)(lds + KBUF0 + nb + soff0) = kr0; *(LAS v4u*)(lds + KBUF0 + nb + soff1) = kr1; *(LAS v4u*)(lds + VBUF0 + nb + soff0) = vr0; *(LAS v4u*)(lds + VBUF0 + nb + soff1) = vr1; }
        __syncthreads();
        { const LAS v4u* fl = (const LAS v4u*)(lds + FLAGS + (it & 1) * 32); const v4u a = fl[0], c2 = fl[1];
          if ((a.x & a.y & a.z & a.w & c2.x & c2.y & c2.z & c2.w) != 0u) break; }
    }
    ATT_LOAD_HEAD(nb, nh, nqb);
    { float ss = 0.f;
#pragma unroll
      for (int c = 0; c < 4; ++c)
#pragma unroll
          for (int r = 0; r < 16; ++r) ss += oT[c][r] * oT[c][r];
      ss = pg8::xsum32(ss);
      const size_t row = rowbase + q0 + qi;
      if (hh == 0) ssq_att[row * 8 + h] = ss;
      bf16* op = mix + row * DM + h * HD + 8 * hh;
#pragma unroll
      for (int c = 0; c < 4; ++c)
#pragma unroll
          for (int g = 0; g < 4; g += 2) {
              const auto rx = __builtin_amdgcn_permlane32_swap(cvtpk(oT[c][4 * g], oT[c][4 * g + 1]), cvtpk(oT[c][4 * g + 4], oT[c][4 * g + 5]), false, false);
              const auto ry = __builtin_amdgcn_permlane32_swap(cvtpk(oT[c][4 * g + 2], oT[c][4 * g + 3]), cvtpk(oT[c][4 * g + 6], oT[c][4 * g + 7]), false, false);
              v4u w; w.x = rx[0]; w.y = ry[0]; w.z = rx[1]; w.w = ry[1]; *(v4u*)(op + 32 * c + 8 * g) = w; } }
}
}

namespace ssd {
using att::f32x16; using att::s16x4; using att::off_b; using att::cvtpk;
constexpr int IMG = 16384, C_IMG = 0, B_IMG = 2 * IMG, X_IMG = 4 * IMG, H_IMG = 6 * IMG;
constexpr int SC_OFF = RING_BYTES + 1024;
constexpr int NCH = SEQ / 64, CSW = CONV_DIM;
__device__ __forceinline__ float wave_incl_scan(float v) {
#define SSD_DPP_ADD(ctrl, rmask) do { const float t_ = __builtin_bit_cast(float, __builtin_amdgcn_update_dpp(0, __builtin_bit_cast(int, v), (ctrl), (rmask), 0xf, true)); v += t_; } while (0)
    SSD_DPP_ADD(0x111, 0xf); SSD_DPP_ADD(0x112, 0xf); SSD_DPP_ADD(0x114, 0xf); SSD_DPP_ADD(0x118, 0xf);
    SSD_DPP_ADD(0x142, 0xa);
    SSD_DPP_ADD(0x143, 0xc);
#undef SSD_DPP_ADD
    return v;
}
__device__ __forceinline__ float softplus_f(float v) { const float e = __expf(v); return v > 20.f ? v : (e < 0.015625f ? e * (1.0f - e * (0.5f - e * (0.33333334f - 0.25f * e))) : __logf(1.0f + e)); }
#define SSD_BAR() do { asm volatile("s_waitcnt lgkmcnt(0)" ::: "memory"); __builtin_amdgcn_s_barrier(); asm volatile("" ::: "memory"); } while (0)

__device__ __forceinline__ void conv_prepass(const bf16* proj, bf16* cs, const float* conv_w, const float* conv_b, int vcu, int G, int tid, LAS unsigned char* lds) {
    const int gt = vcu * NT + tid, NGT = G * NT; constexpr int NIT = (M / 8) * (CSW / 8);
    LAS float* wl = (LAS float*)lds;
    __syncthreads();
    for (int i = tid; i < 5 * CONV_DIM / 4; i += NT) ((LAS f32x4*)wl)[i] = (i < CONV_DIM) ? ((const f32x4*)conv_w)[i] : ((const f32x4*)conv_b)[i - CONV_DIM];
    __syncthreads();
    v4u nraw[11];
#define CP_LOAD(it_) do { const int ch_ = (it_) % (CSW / 8), rb_ = (it_) / (CSW / 8); const int row0_ = 8 * rb_, t0_ = row0_ % SEQ; const bf16* src_ = proj + (size_t)row0_ * NPROJ + COL_XBC + 8 * ch_; \
        _Pragma("unroll") for (int i_ = 0; i_ < 11; ++i_) { if (t0_ - 3 + i_ >= 0) nraw[i_] = *(const v4u*)(src_ + (ptrdiff_t)(i_ - 3) * NPROJ); else { nraw[i_].x = 0u; nraw[i_].y = 0u; nraw[i_].z = 0u; nraw[i_].w = 0u; } } } while (0)
    if (gt < NIT) CP_LOAD(gt);
    for (int it = gt; it < NIT; it += NGT) {
        const int ch = it % (CSW / 8), rb = it / (CSW / 8); const int row0 = 8 * rb;
        v4u raw[11];
#pragma unroll
        for (int i = 0; i < 11; ++i) raw[i] = nraw[i];
        float cw[4][8], cb[8];
        { const f32x4 b0 = *(const LAS f32x4*)(wl + 4 * CONV_DIM + 8 * ch), b1 = *(const LAS f32x4*)(wl + 4 * CONV_DIM + 8 * ch + 4);
#pragma unroll
          for (int j = 0; j < 4; ++j) { cb[j] = b0[j]; cb[4 + j] = b1[j]; }
#pragma unroll
          for (int k = 0; k < 4; ++k) { const f32x4 w0 = *(const LAS f32x4*)(wl + k * CONV_DIM + 8 * ch), w1 = *(const LAS f32x4*)(wl + k * CONV_DIM + 8 * ch + 4);
#pragma unroll
              for (int j = 0; j < 4; ++j) { cw[k][j] = w0[j]; cw[k][4 + j] = w1[j]; } } }
        if (it + NGT < NIT) CP_LOAD(it + NGT);
#pragma unroll
        for (int i = 0; i < 8; ++i) { float o[8];
#pragma unroll
            for (int j = 0; j < 8; ++j) o[j] = cb[j];
#pragma unroll
            for (int k = 0; k < 4; ++k) { const v4u u = raw[i + k];
                o[0] += cw[k][0] * bflo(u.x); o[1] += cw[k][1] * bfhi(u.x); o[2] += cw[k][2] * bflo(u.y); o[3] += cw[k][3] * bfhi(u.y);
                o[4] += cw[k][4] * bflo(u.z); o[5] += cw[k][5] * bfhi(u.z); o[6] += cw[k][6] * bflo(u.w); o[7] += cw[k][7] * bfhi(u.w); }
            { float e[8];
              __builtin_amdgcn_sched_barrier(0);
#pragma unroll
              for (int j = 0; j < 8; ++j) e[j] = __builtin_amdgcn_exp2f(o[j] * -1.4426950408889634f);
              __builtin_amdgcn_sched_barrier(0);
#pragma unroll
              for (int j = 0; j < 8; ++j) e[j] = __builtin_amdgcn_rcpf(1.0f + e[j]);
              __builtin_amdgcn_sched_barrier(0);
#pragma unroll
              for (int j = 0; j < 8; ++j) o[j] = o[j] * e[j]; }
            v4u w; w.x = cvtpk(o[0], o[1]); w.y = cvtpk(o[2], o[3]); w.z = cvtpk(o[4], o[5]); w.w = cvtpk(o[6], o[7]);
            *(v4u*)(cs + (size_t)(row0 + i) * CSW + 8 * ch) = w; }
    }
#undef CP_LOAD
}

__device__ __forceinline__ void ssd_unit(const bf16* proj, const bf16* cs, const float* dtbuf, bf16* mix, float* ssq_ssm  , float dtb, float a, float Dh,
                                         int b, int head, LAS unsigned char* lds, int tid) {
    const int lane = tid & 63, wave = __builtin_amdgcn_readfirstlane(tid >> 6), g = head >> 3;
    const size_t rowbase = (size_t)b * SEQ;
    LAS float* dtv = (LAS float*)(lds + SC_OFF); LAS float* acm = dtv + 128; LAS float* wvv = dtv + 256;
    __syncthreads();
    { v4u z4; z4.x = 0u; z4.y = 0u; z4.z = 0u; z4.w = 0u; *(LAS v4u*)(lds + H_IMG + tid * 32) = z4; *(LAS v4u*)(lds + H_IMG + tid * 32 + 16) = z4; }
    if (wave >= 6) {
        v4u rgA[20], rgB[20]; float dtA = 0.f, dtB = 0.f;
#define SSD_LOAD(rg, dtraw, cn) do { int lz_ = lane; asm volatile("" : "+v"(lz_)); const int cn_ = (cn) < NCH ? (cn) : NCH - 1; const bf16* base_ = cs + (rowbase + 64 * cn_) * CSW; \
        if (wave == 6) { _Pragma("unroll") for (int k_ = 0; k_ < 16; ++k_) rg[k_] = *(const v4u*)(base_ + (size_t)((lz_ >> 4) + 4 * k_) * CSW + 1280 + 128 * g + 8 * (lz_ & 15)); \
                         _Pragma("unroll") for (int k_ = 0; k_ < 4; ++k_) rg[16 + k_] = *(const v4u*)(base_ + (size_t)((lz_ >> 3) + 8 * k_) * CSW + 64 * head + 8 * (lz_ & 7)); } \
        else { _Pragma("unroll") for (int k_ = 0; k_ < 16; ++k_) rg[k_] = *(const v4u*)(base_ + (size_t)((lz_ >> 4) + 4 * k_) * CSW + 1024 + 128 * g + 8 * (lz_ & 15)); \
               _Pragma("unroll") for (int k_ = 4; k_ < 8; ++k_) rg[12 + k_] = *(const v4u*)(base_ + (size_t)((lz_ >> 3) + 8 * k_) * CSW + 64 * head + 8 * (lz_ & 7)); } \
        dtraw = dtbuf[(rowbase + 64 * cn_ + lz_) * 16 + head]; } while (0)        \

#define SSD_PUT(rg, dtraw, buf) do { int lz_ = lane; asm volatile("" : "+v"(lz_)); \
        if (wave == 6) { _Pragma("unroll") for (int k_ = 0; k_ < 16; ++k_) *(LAS v4u*)(lds + C_IMG + (buf) * IMG + off_b((lz_ >> 4) + 4 * k_, lz_ & 15)) = rg[k_]; \
                         _Pragma("unroll") for (int k_ = 0; k_ < 4; ++k_) *(LAS v4u*)(lds + X_IMG + (buf) * IMG + off_b((lz_ >> 3) + 8 * k_, lz_ & 7)) = rg[16 + k_]; } \
        else { _Pragma("unroll") for (int k_ = 0; k_ < 16; ++k_) *(LAS v4u*)(lds + B_IMG + (buf) * IMG + off_b((lz_ >> 4) + 4 * k_, lz_ & 15)) = rg[k_]; \
               _Pragma("unroll") for (int k_ = 4; k_ < 8; ++k_) *(LAS v4u*)(lds + X_IMG + (buf) * IMG + off_b((lz_ >> 3) + 8 * k_, lz_ & 7)) = rg[12 + k_]; \
               const float dt_ = softplus_f(dtraw + dtb); float ac_ = dt_ * a; \
               ac_ = wave_incl_scan(ac_); \
               const float tot_ = __builtin_bit_cast(float, __builtin_amdgcn_readlane(__builtin_bit_cast(int, ac_), 63)); dtv[(buf) * 64 + lane] = ac_ * 1.44269504f - __log2f(dt_); acm[(buf) * 64 + lane] = ac_; wvv[(buf) * 64 + lane] = dt_ * __expf(tot_ - ac_); } } while (0)
        SSD_LOAD(rgA, dtA, 0); SSD_LOAD(rgB, dtB, 1); SSD_PUT(rgA, dtA, 0); SSD_LOAD(rgA, dtA, 2);
        SSD_BAR();
        for (int c = 0; c < NCH; c += 2) {
            SSD_PUT(rgB, dtB, (c + 1) & 1); SSD_LOAD(rgB, dtB, c + 3);
            SSD_BAR();
            SSD_PUT(rgA, dtA, (c + 2) & 1); SSD_LOAD(rgA, dtA, c + 4);
            SSD_BAR();
        }
#undef SSD_LOAD
#undef SSD_PUT
    } else if (wave < 4) {
        const int lb = wave & 1, pb = wave >> 1;
        v2u zn[4];
        { int lz0 = lane; asm volatile("" : "+v"(lz0));
          const bf16* zp = proj + (rowbase + 32 * lb + (lz0 & 31)) * NPROJ + COL_Z + 64 * head + 32 * pb + 4 * (lz0 >> 5);
#pragma unroll
          for (int g4 = 0; g4 < 4; ++g4) zn[g4] = *(const v2u*)(zp + 8 * g4); }
        SSD_BAR();
        for (int c = 0; c < NCH; ++c) {
            int lz = lane; asm volatile("" : "+v"(lz));
            const int qi = lz & 31, hh = lz >> 5, l = 32 * lb + qi;
            const unsigned kbase = off_b(qi, hh);
            unsigned vbase[2], nbase[2];
            { const unsigned blk = (lz >> 4) & 1, q4 = (lz & 15) >> 2, p = lz & 3;
#pragma unroll
              for (int t = 0; t < 2; ++t) { vbase[t] = off_b(8 * t + 4 * hh + q4, 2 * blk + (p >> 1)) + 8 * (p & 1); nbase[t] = off_b(8 * hh + 4 * t + q4, 2 * blk + (p >> 1)) + 8 * (p & 1); } }
            const int cur = c & 1; const size_t row = rowbase + 64 * c + l;
            const LAS unsigned char* Cim = lds + C_IMG + cur * IMG; const LAS unsigned char* Bim = lds + B_IMG + cur * IMG; const LAS unsigned char* Xim = lds + X_IMG + cur * IMG; const LAS unsigned char* Him = lds + H_IMG + cur * IMG;
            v2u zr[4];
#pragma unroll
            for (int g4 = 0; g4 < 4; ++g4) zr[g4] = zn[g4];
            if (c + 1 < NCH) {
#pragma unroll
                for (int g4 = 0; g4 < 4; ++g4) zn[g4] = *(const v2u*)(proj + (row + 64) * NPROJ + COL_Z + 64 * head + 32 * pb + 8 * g4 + 4 * hh); }
            bf16x8 cf[8];
#pragma unroll
            for (int ks = 0; ks < 8; ++ks) cf[ks] = *(const LAS bf16x8*)(Cim + ((kbase ^ (unsigned)(ks << 5)) + 8192u * lb));
            f32x16 y, y2;
#pragma unroll
            for (int r = 0; r < 16; ++r) { y[r] = 0.f; y2[r] = 0.f; }
#pragma unroll
            for (int ks = 0; ks < 4; ++ks) {
                const s16x4 h0 = __builtin_amdgcn_ds_read_tr16_b64_v4i16((LAS s16x4*)(Him + ((nbase[0] ^ (unsigned)(pb << 6)) + 4096u * ks)));
                const s16x4 h1 = __builtin_amdgcn_ds_read_tr16_b64_v4i16((LAS s16x4*)(Him + ((nbase[1] ^ (unsigned)(pb << 6)) + 4096u * ks)));
                const s16x4 h2 = __builtin_amdgcn_ds_read_tr16_b64_v4i16((LAS s16x4*)(Him + ((nbase[0] ^ (unsigned)((2 + pb) << 6)) + 4096u * ks)));
                const s16x4 h3 = __builtin_amdgcn_ds_read_tr16_b64_v4i16((LAS s16x4*)(Him + ((nbase[1] ^ (unsigned)((2 + pb) << 6)) + 4096u * ks)));
                y = __builtin_amdgcn_mfma_f32_32x32x16_bf16(__builtin_shufflevector(h0, h1, 0, 1, 2, 3, 4, 5, 6, 7), cf[ks], y, 0, 0, 0);
                y2 = __builtin_amdgcn_mfma_f32_32x32x16_bf16(__builtin_shufflevector(h2, h3, 0, 1, 2, 3, 4, 5, 6, 7), cf[4 + ks], y2, 0, 0, 0); }
            const float al = acm[cur * 64 + l]; const float el = __expf(al), al2 = al * 1.44269504f;
#pragma unroll
            for (int r = 0; r < 16; ++r) y[r] = (y[r] + y2[r]) * el;
#pragma unroll
            for (int sb = 0; sb < 2; ++sb) {
                if (sb <= lb) {
                    f32x16 ga, gb;
#pragma unroll
                    for (int r = 0; r < 16; ++r) { ga[r] = 0.f; gb[r] = 0.f; }
#pragma unroll
                    for (int ks = 0; ks < 8; ks += 2) { const bf16x8 b0 = *(const LAS bf16x8*)(Bim + ((kbase ^ (unsigned)(ks << 5)) + 8192u * sb)), b1 = *(const LAS bf16x8*)(Bim + ((kbase ^ (unsigned)((ks + 1) << 5)) + 8192u * sb));
                        ga = __builtin_amdgcn_mfma_f32_32x32x16_bf16(b0, cf[ks], ga, 0, 0, 0); gb = __builtin_amdgcn_mfma_f32_32x32x16_bf16(b1, cf[ks + 1], gb, 0, 0, 0); }
#pragma unroll
                    for (int r = 0; r < 16; ++r) ga[r] += gb[r];
                    float W[16];
#pragma unroll
                    for (int g4 = 0; g4 < 4; ++g4) { const int sq = 32 * sb + 8 * g4 + 4 * hh; const f32x4 as4 = *(const LAS f32x4*)(dtv + cur * 64 + sq);
#pragma unroll
                        for (int i = 0; i < 4; ++i) { float m = ga[4 * g4 + i] * __builtin_amdgcn_exp2f(al2 - as4[i]); if (sb == lb) m = (sq + i <= l) ? m : 0.f; W[4 * g4 + i] = m; } }
#pragma unroll
                    for (int s2 = 0; s2 < 2; ++s2) {
                        v4u wp; wp.x = cvtpk(W[8 * s2], W[8 * s2 + 1]); wp.y = cvtpk(W[8 * s2 + 2], W[8 * s2 + 3]); wp.z = cvtpk(W[8 * s2 + 4], W[8 * s2 + 5]); wp.w = cvtpk(W[8 * s2 + 6], W[8 * s2 + 7]);
                        const bf16x8 wf = __builtin_bit_cast(bf16x8, wp);
                        const s16x4 lo = __builtin_amdgcn_ds_read_tr16_b64_v4i16((LAS s16x4*)(Xim + ((vbase[0] ^ (unsigned)(pb << 6)) + 4096u * s2 + 8192u * sb)));
                        const s16x4 hi = __builtin_amdgcn_ds_read_tr16_b64_v4i16((LAS s16x4*)(Xim + ((vbase[1] ^ (unsigned)(pb << 6)) + 4096u * s2 + 8192u * sb)));
                        const bf16x8 xf = __builtin_shufflevector(lo, hi, 0, 1, 2, 3, 4, 5, 6, 7);
                        y = __builtin_amdgcn_mfma_f32_32x32x16_bf16(xf, wf, y, 0, 0, 0); }
                }
            }
            { float ss = 0.f; bf16* op = mix + row * DM + 1024 + 64 * head + 32 * pb + 8 * hh; v2u wq[4];
#pragma unroll
              for (int g4 = 0; g4 < 4; ++g4) { const v2u xw = *(const LAS v2u*)(Xim + off_b(l, 4 * pb + g4) + 8 * hh);
                  const float xv[4] = {bflo(xw.x), bfhi(xw.x), bflo(xw.y), bfhi(xw.y)}, zv[4] = {bflo(zr[g4].x), bfhi(zr[g4].x), bflo(zr[g4].y), bfhi(zr[g4].y)};
                  float o[4];
#pragma unroll
                  for (int i = 0; i < 4; ++i) { o[i] = (y[4 * g4 + i] + Dh * xv[i]) * zv[i]; ss += o[i] * o[i]; }
                  wq[g4].x = cvtpk(o[0], o[1]); wq[g4].y = cvtpk(o[2], o[3]); }
#pragma unroll
              for (int g4 = 0; g4 < 4; g4 += 2) {
                  const auto rx = __builtin_amdgcn_permlane32_swap(wq[g4].x, wq[g4 + 1].x, false, false); const auto ry = __builtin_amdgcn_permlane32_swap(wq[g4].y, wq[g4 + 1].y, false, false);
                  v4u w; w.x = rx[0]; w.y = ry[0]; w.z = rx[1]; w.w = ry[1]; *(v4u*)(op + 8 * g4) = w; }
              ss = pg8::xsum32(ss);
              if (hh == 0) ssq_ssm[row * 32 + head * 2 + pb] = ss; }
            SSD_BAR();
        }
    } else {
        const int pbh = wave - 4;
        f32x16 hacc[4];
#pragma unroll
        for (int j = 0; j < 4; ++j)
#pragma unroll
            for (int r = 0; r < 16; ++r) hacc[j][r] = 0.f;
        SSD_BAR();
        for (int c = 0; c < NCH; ++c) {
            int lz = lane; asm volatile("" : "+v"(lz));
            const int qi = lz & 31, hh = lz >> 5;
            unsigned nbase[2];
            { const unsigned blk = (lz >> 4) & 1, q4 = (lz & 15) >> 2, p = lz & 3;
#pragma unroll
              for (int t = 0; t < 2; ++t) nbase[t] = off_b(8 * hh + 4 * t + q4, 2 * blk + (p >> 1)) + 8 * (p & 1); }
            const int cur = c & 1, nxt = cur ^ 1;
            const LAS unsigned char* Bim = lds + B_IMG + cur * IMG; const LAS unsigned char* Xim = lds + X_IMG + cur * IMG; LAS unsigned char* Hn = lds + H_IMG + nxt * IMG;
            const float eA = __expf(acm[cur * 64 + 63]);
#pragma unroll
            for (int j = 0; j < 4; ++j)
#pragma unroll
                for (int r = 0; r < 16; ++r) hacc[j][r] *= eA;
#pragma unroll
            for (int k4 = 0; k4 < 4; ++k4) {
                const s16x4 xl = __builtin_amdgcn_ds_read_tr16_b64_v4i16((LAS s16x4*)(Xim + ((nbase[0] ^ (unsigned)(pbh << 6)) + 4096u * k4)));
                const s16x4 xh = __builtin_amdgcn_ds_read_tr16_b64_v4i16((LAS s16x4*)(Xim + ((nbase[1] ^ (unsigned)(pbh << 6)) + 4096u * k4)));
                const f32x4 w0 = *(const LAS f32x4*)(wvv + cur * 64 + 16 * k4 + 8 * hh), w1 = *(const LAS f32x4*)(wvv + cur * 64 + 16 * k4 + 8 * hh + 4);
                v4u xp; xp.x = cvtpk(bf1((bf16)xl[0]) * w0[0], bf1((bf16)xl[1]) * w0[1]); xp.y = cvtpk(bf1((bf16)xl[2]) * w0[2], bf1((bf16)xl[3]) * w0[3]);
                        xp.z = cvtpk(bf1((bf16)xh[0]) * w1[0], bf1((bf16)xh[1]) * w1[1]); xp.w = cvtpk(bf1((bf16)xh[2]) * w1[2], bf1((bf16)xh[3]) * w1[3]);
                const bf16x8 xa = __builtin_bit_cast(bf16x8, xp);
#pragma unroll
                for (int j = 0; j < 4; ++j) {
                    const s16x4 bl = __builtin_amdgcn_ds_read_tr16_b64_v4i16((LAS s16x4*)(Bim + ((nbase[0] ^ (unsigned)(j << 6)) + 4096u * k4)));
                    const s16x4 bh = __builtin_amdgcn_ds_read_tr16_b64_v4i16((LAS s16x4*)(Bim + ((nbase[1] ^ (unsigned)(j << 6)) + 4096u * k4)));
                    const bf16x8 bb = __builtin_shufflevector(bl, bh, 0, 1, 2, 3, 4, 5, 6, 7);
                    hacc[j] = __builtin_amdgcn_mfma_f32_32x32x16_bf16(xa, bb, hacc[j], 0, 0, 0); } }
            if (c + 1 < NCH) {
                const unsigned x16 = 16u * ((((unsigned)qi & 3u) << 2) | (((unsigned)qi >> 2) & 3u));
#pragma unroll
                for (int j = 0; j < 4; ++j)
#pragma unroll
                    for (int g4 = 0; g4 < 4; ++g4) { v2u w; w.x = cvtpk(hacc[j][4 * g4], hacc[j][4 * g4 + 1]); w.y = cvtpk(hacc[j][4 * g4 + 2], hacc[j][4 * g4 + 3]);
                        *(LAS v2u*)(Hn + 256u * (32 * (j & 1) + qi) + ((16u * (unsigned)(8 * (j >> 1) + 4 * pbh + g4)) ^ x16) + 8u * hh) = w; } }
            SSD_BAR();
        }
    }
}
#undef SSD_BAR
}

struct Args { const float* in[17]; float* out; unsigned char* ws; int l_lo, l_hi, ph_lo, ph_hi, do_pro, use_bar, pad0, pad1; };
typedef const Args __attribute__((address_space(4))) CArgs;
__device__ __forceinline__ CArgs* kargs() { CArgs* p = (CArgs*)__builtin_amdgcn_kernarg_segment_ptr(); asm volatile("" : "+s"(p)); return p; }
__device__ __forceinline__ int tid_of(int wave_id) { int t = threadIdx.x; asm volatile("" : "+v"(t)); return t; }
__device__ __forceinline__ int vcu_of(int bx, int G) { return (G % 8 == 0) ? (bx % 8) * (G / 8) + bx / 8 : bx; }
__device__ __forceinline__ void grid_bar(LAS unsigned char* lds) {
    CArgs* A = kargs(); if (!A->use_bar) return;
    XcdBarrier b; b.bar = (unsigned*)(A->ws + WS_CTL) + CW_BAR; b.x = xb_xcc_id(); b.st = (volatile LAS unsigned*)(lds + MISC_OFF) + 8;
    xcd_barrier(b);
}
__device__ __forceinline__ int build_rstd_tbl(const float* ssq, LAS float* tbl, int N_, int tid) {
    pg8::StaticOrder S; S.init(M, N_, (int)gridDim.x, (int)blockIdx.x); pg8::Unit u0;
    if (!S.next(0, u0)) return 0;
    const int gid0 = u0.pm >> 3, pmlo = u0.pm & 7; bool ok = true;
    for (int i = 1;; ++i) { pg8::Unit u; if (!S.next(i, u)) break; ok = ok && ((u.pm & 7) == pmlo) && ((u.pm >> 3) >= gid0) && ((u.pm >> 3) < gid0 + 4); }
    const int r = tid >> 1, half = tid & 1;
#pragma unroll
    for (int slot = 0; slot < 4; ++slot) { const int pm = (gid0 + slot) * 8 + pmlo;
        if (pm < M / 256) { const f32x4* p = (const f32x4*)(ssq + ((size_t)pm * 256 + r) * 32 + 16 * half); float sm = 0.f;
#pragma unroll
            for (int i = 0; i < 4; ++i) { const f32x4 v = p[i]; sm += (v[0] + v[1]) + (v[2] + v[3]); }
            sm += __shfl_xor(sm, 1);
            if (half == 0) tbl[slot * 256 + r] = ok ? 1.0f / sqrtf(sm * (1.0f / DM) + EPS) : __builtin_nanf(""); } }
    return gid0;
}
#ifndef RESID_WGM
#define RESID_WGM 4
#endif
__device__ __forceinline__ void build_mix_tbl(const float* ssq_att, const float* ssq_ssm, LAS float* ftab, int tid) {
    pg8::StaticOrder S; S.init(M, DM, (int)gridDim.x, (int)blockIdx.x, RESID_WGM);
    unsigned used = 0u; bool ok = true;
    const int r = tid >> 1, half = tid & 1;
    for (int i = 0;; ++i) { pg8::Unit u; if (!S.next(i, u)) break;
        const int slot = (u.pm >> 2) & 3; ok = ok && !((used >> slot) & 1u) && i < 4; used |= 1u << slot;
        const size_t row = (size_t)u.pm * 256 + r;
        const f32x4* ps = (const f32x4*)(ssq_ssm + row * 32 + 16 * half); float sg = 0.f;
#pragma unroll
        for (int k = 0; k < 4; ++k) { const f32x4 v = ps[k]; sg += (v[0] + v[1]) + (v[2] + v[3]); }
        const f32x4* pa = (const f32x4*)(ssq_att + row * 8); const f32x4 a0 = pa[0], a1 = pa[1];
        const float sa = ((a0[0] + a0[1]) + (a0[2] + a0[3])) + ((a1[0] + a1[1]) + (a1[2] + a1[3]));
        const float rg = 1.0f / sqrtf(sg * (1.0f / 512.f) + EPS), ra = 1.0f / sqrtf(sa * (1.0f / 1024.f) + EPS);
        const float rg_other = __shfl_xor(rg, 1);
        if (half == 0) { const float qn = __builtin_nanf("");
            ftab[slot * 768 + r] = ok ? ra / rg : qn; ftab[slot * 768 + 256 + r] = ok ? rg / rg_other : qn; ftab[slot * 768 + 512 + r] = ok ? rg_other : qn; } }
}
#ifndef PH_MASK
#define PH_MASK 0xFF
#endif
#define IN(k) (((PH_MASK >> (k)) & 1) && kargs()->ph_lo <= (k) && (k) < kargs()->ph_hi)
#ifndef PROBE_DUP
#define PROBE_DUP 0
#endif
#define REPS(k) for (int rep_ = 0; rep_ < (((PROBE_DUP) >> (k)) & 1) + 1; ++rep_)

__global__ void __launch_bounds__(NT, 2) mk_fwd(Args args) {
    extern __shared__ __attribute__((aligned(16))) unsigned char lds_raw[];
    LAS unsigned char* lds = (LAS unsigned char*)lds_raw;
    const int wv = __builtin_amdgcn_readfirstlane(threadIdx.x >> 6);
    { const int tid = threadIdx.x;
      for (int u = tid; u < (LDS_BYTES - RING_BYTES) / 4; u += NT) ((LAS unsigned*)(lds + RING_BYTES))[u] = 0u;
      __syncthreads();
      if (args.use_bar) (void)xcd_barrier_post((unsigned*)(args.ws + WS_CTL) + CW_BAR, (volatile LAS unsigned*)(lds + MISC_OFF) + 8); }

    if ((PH_MASK & 1) && kargs()->do_pro) {
        CArgs* A = kargs(); const int tid = tid_of(wv), lane = tid & 63, wave = __builtin_amdgcn_readfirstlane(tid >> 6); const int G = gridDim.x, vcu = vcu_of(blockIdx.x, G);
        Ptrs P;
        P.x = A->in[0]; P.norm_mix = A->in[1]; P.w_in = A->in[2]; P.q_gain = A->in[3]; P.k_gain = A->in[4]; P.conv_w = A->in[5]; P.conv_b = A->in[6]; P.dt_bias = A->in[7];
        P.a_log = A->in[8]; P.d_skip = A->in[9]; P.attn_gain = A->in[10]; P.ssm_gain = A->in[11]; P.w_out = A->in[12]; P.norm_ffn = A->in[13]; P.w_gate = A->in[14]; P.w_up = A->in[15]; P.w_down = A->in[16];
        P.out = A->out; P.ws = A->ws;
        REPS(0) { prologue(P, lds, vcu, G, wave, lane); grid_bar(lds); } }

    for (int l = kargs()->l_lo; l < kargs()->l_hi; ++l) {
#define WSP(off) (kargs()->ws + (off))
#define BUF_X ((bf16*)kargs()->out)
#define BUF_V ((bf16*)WSP(WS_XB1))
#define BUF_Z ((bf16*)WSP(WS_XB0))
#define CS_BUF ((bf16*)((unsigned char*)kargs()->out + 128 * MiB))
#define SSQ(k) ((float*)WSP(WS_SSQ + (k)))
        REPS(1) if (IN(1)) {
            { const int tid = tid_of(wv), lane = tid & 63, wave = __builtin_amdgcn_readfirstlane(tid >> 6); const int G = gridDim.x;
              dt_pass(BUF_X, (const bf16*)WSP(WS_WDT) + (size_t)l * 16 * DM, SSQ(SSQ_X0), (float*)WSP(WS_DT), vcu_of(blockIdx.x, G), G, wave, lane, lds); __syncthreads(); }
            pg8::Gemm g{BUF_X, (const bf16*)WSP(WS_WIN) + (size_t)l * NPROJ * DM, M, NPROJ, DM, DM, DM}; pg8::StaticOrder S; S.init(M, NPROJ, (int)gridDim.x, (int)blockIdx.x);
            int gid0;
            { const int tid = tid_of(wv); gid0 = build_rstd_tbl(SSQ(SSQ_X0), (LAS float*)(lds + TBL_OFF), NPROJ, tid);
              if (tid < 256) ((LAS float*)(lds + GAIN_OFF))[tid] = (tid < 128) ? kargs()->in[3][l * HD + tid] * pg8::QSCALE : kargs()->in[4][l * HD + tid - 128];
              __syncthreads(); }
            pg8::EpiProj E{(bf16*)WSP(WS_PROJ), NPROJ, SSQ(SSQ_X0), 1.0f / DM, (const LAS float*)(lds + GAIN_OFF), (LAS float*)(lds + XCH_OFF), (const LAS float*)(lds + TBL_OFF), gid0};
            pg8::gemm_phase<pg8::EpiProj, pg8::StaticOrder, true, true>(lds, g, S, E, wv);
            grid_bar(lds);
        }
        REPS(2) { if (IN(2)) {
            const int tid = tid_of(wv); const int G = gridDim.x;
            ssd::conv_prepass((const bf16*)WSP(WS_PROJ), CS_BUF, kargs()->in[5] + (size_t)l * 4 * CONV_DIM, kargs()->in[6] + (size_t)l * CONV_DIM, vcu_of(blockIdx.x, G), G, tid, lds);
            { att::bf16x8_t qf[8]; v4u kr0, kr1, vr0, vr1; const bf16* proj = (const bf16*)WSP(WS_PROJ);
              { const int i0 = (int)blockIdx.x < BATCH * NH * 8 ? (int)blockIdx.x : 0; const int bh = i0 % 128, qb = 7 - i0 / 128; ATT_LOAD_HEAD(bh >> 3, bh & 7, qb); }
              for (int i = blockIdx.x; i < BATCH * NH * 8; i += G) { const int bh = i % 128, qb = 7 - i / 128;
                  const int i2 = (i + G < BATCH * NH * 8) ? i + G : i; const int bh2 = i2 % 128, qb2 = 7 - i2 / 128;
                  att::attn_unit(proj, BUF_V, SSQ(SSQ_ATT), bh >> 3, bh & 7, qb, lds, tid, qf, kr0, kr1, vr0, vr1, bh2 >> 3, bh2 & 7, qb2); } }
            grid_bar(lds);
        }
        if (IN(3)) {
            CArgs* A = kargs(); const int tid = tid_of(wv); const int G = gridDim.x;
            for (int i = vcu_of(blockIdx.x, G); i < BATCH * SNH; i += G) { const int b = i >> 4, head = i & 15;
                ssd::ssd_unit((const bf16*)WSP(WS_PROJ), CS_BUF, (const float*)WSP(WS_DT), BUF_V, SSQ(SSQ_SSM),
                            A->in[7][l * SNH + head], -__expf(A->in[8][l * SNH + head]), A->in[9][l * SNH + head], b, head, lds, tid); }
            grid_bar(lds);
        } }
        if (IN(5)) {
            pg8::Gemm g{BUF_V, (const bf16*)WSP(WS_WOUT) + (size_t)l * DM * DM, M, DM, DM, DM, DM}; pg8::KSegOrder S; S.init(M, DM, (int)gridDim.x, (int)blockIdx.x, RESID_WGM);
            { const int tid = tid_of(wv); build_mix_tbl(SSQ(SSQ_ATT), SSQ(SSQ_SSM), (LAS float*)(lds + FTAB_OFF), tid); __syncthreads(); }
            pg8::EpiResid<true> E{BUF_X, BUF_Z, kargs()->out, SSQ(SSQ_X1), DM, 0, (const LAS float*)(lds + FTAB_OFF)};
            pg8::gemm_phase<pg8::EpiResid<true>, pg8::KSegOrder, true, true>(lds, g, S, E, wv);
            grid_bar(lds);
        }
        REPS(6) if (IN(6)) {
            pg8::Gemm g{BUF_Z, (const bf16*)WSP(WS_WGU) + (size_t)l * 2 * DFF * DM, M, 2 * DFF, DM, DM, DM}; pg8::StaticOrder S; S.init(M, 2 * DFF, (int)gridDim.x, (int)blockIdx.x);
            int gid0;
            { const int tid = tid_of(wv); gid0 = build_rstd_tbl(SSQ(SSQ_X1), (LAS float*)(lds + TBL_OFF), 2 * DFF, tid); __syncthreads(); }
            pg8::EpiSwiGLU E{(bf16*)WSP(WS_PROJ), DFF_LD, SSQ(SSQ_X1), 1.0f / DM, (const LAS float*)(lds + TBL_OFF), gid0};
            pg8::gemm_phase<pg8::EpiSwiGLU, pg8::StaticOrder, true, true>(lds, g, S, E, wv);
            grid_bar(lds);
        }
        if (IN(7)) {
            pg8::Gemm g{(const bf16*)WSP(WS_PROJ), (const bf16*)WSP(WS_WDN) + (size_t)l * DM * DFF_LD, M, DM, DFF, DFF_LD, DFF_LD}; pg8::StaticOrder S; S.init(M, DM, (int)gridDim.x, (int)blockIdx.x, RESID_WGM);
            pg8::EpiResid<false> E{BUF_Z, BUF_X, kargs()->out, SSQ(SSQ_X0), DM, (l + 1 == DEPTH) ? 1 : 0, (const LAS float*)nullptr};
            pg8::gemm_phase<pg8::EpiResid<false>, pg8::StaticOrder, true, true>(lds, g, S, E, wv);
            if (l + 1 < kargs()->l_hi) grid_bar(lds);
        }
    }
#undef IN
}

extern "C" void kernel_launch(void* const* d_in, const int* in_sizes, int n_in, void* d_out, int out_size, void* d_ws, size_t ws_size, hipStream_t stream) {
    static int grid = 0;
    if (grid == 0) {
        if (n_in != 17 || in_sizes[0] != M * DM || out_size != M * DM || ws_size < WS_END) { fprintf(stderr, "kernel_launch: shape/workspace mismatch (n_in %d, in0 %d, out %d, ws %zu < %zu); nothing launched\n", n_in, n_in > 0 ? in_sizes[0] : -1, out_size, ws_size, (size_t)WS_END); grid = -1; return; }
        int dev = 0, cus = 0, per_cu = 0;
        if (hipGetDevice(&dev) != hipSuccess || hipDeviceGetAttribute(&cus, hipDeviceAttributeMultiprocessorCount, dev) != hipSuccess) { grid = -1; return; }
        if (hipFuncSetAttribute((const void*)mk_fwd, hipFuncAttributeMaxDynamicSharedMemorySize, LDS_BYTES) != hipSuccess) { fprintf(stderr, "kernel_launch: hipFuncSetAttribute failed\n"); grid = -1; return; }
        if (hipOccupancyMaxActiveBlocksPerMultiprocessor(&per_cu, (const void*)mk_fwd, NT, LDS_BYTES) != hipSuccess || per_cu < 1) fprintf(stderr, "kernel_launch: note: occupancy query reports %d\n", per_cu);
        (void)hipGetLastError();
        grid = cus;
    }
    if (grid < 0) return;
    if (hipMemsetAsync((char*)d_ws, 0, ZERO_BYTES, stream) != hipSuccess) { fprintf(stderr, "kernel_launch: memset failed\n"); return; }
    Args a{};
    for (int i = 0; i < 17; ++i) a.in[i] = (const float*)d_in[i];
    a.out = (float*)d_out; a.ws = (unsigned char*)d_ws;
#if MK_ONE_LAUNCH
    a.l_lo = 0; a.l_hi = DEPTH; a.ph_lo = 1; a.ph_hi = N_PHASES + 1; a.do_pro = 1; a.use_bar = 1;
    hipLaunchKernelGGL(mk_fwd, dim3(grid), dim3(NT), LDS_BYTES, stream, a);
#else
    a.use_bar = 0;
    a.do_pro = 1; a.l_lo = 0; a.l_hi = 0; a.ph_lo = 0; a.ph_hi = 0;
    hipLaunchKernelGGL(mk_fwd, dim3(grid), dim3(NT), LDS_BYTES, stream, a);
    a.do_pro = 0;
    for (int l = 0; l < DEPTH; ++l)
        for (int ph = 1; ph <= N_PHASES; ++ph) { a.l_lo = l; a.l_hi = l + 1; a.ph_lo = ph; a.ph_hi = ph + 1;
            hipLaunchKernelGGL(mk_fwd, dim3(grid), dim3(NT), LDS_BYTES, stream, a); }
#endif
    const hipError_t le = hipPeekAtLastError();
    if (le != hipSuccess) fprintf(stderr, "kernel_launch: launch failed: %s\n", hipGetErrorName(le));
}
```
